# Optimizing an MI355X kernel written in HIP

```python
import math
import jax, jax.numpy as jnp
from jax import lax
import numpy as np

D_MODEL = 1024
BATCH = 4
SEQ = 8192
DEPTH = 2

GRID_W = 64
CTX_LEN = 256
N_BRANCH = 3
SGU_WIDTH = 512
SGU_GROUPS = 4
SGU_CHUNK = 128
S5_WIDTH = 384
S5_GROUP = 16
S5_GROUPS = S5_WIDTH // S5_GROUP
S5_STATE = 64
S5_DT_MIN = 1e-3
S5_DT_MAX = 1e-1
NA_HEADS = 8
NA_HEAD_DIM = 64
NA_WIDTH = NA_HEADS * NA_HEAD_DIM
NA_KR = 8
NA_KC = 16
ROPE_BASE = 10000.0
N_GROUPS = 4
EXPERTS_PER_GROUP = 8
N_EXPERTS = N_GROUPS * EXPERTS_PER_GROUP
TOP_K = 2
D_EXPERT = 256
ADA_CHUNKS = 6
IN_WIDTH = 2 * SGU_WIDTH + S5_WIDTH + 3 * NA_WIDTH + N_BRANCH * D_MODEL
EPS = 1e-6
NEG_INF = -1e30

kernel_name = 'hybrid_parallel_mixer_hmoe_prefix_dit'


def rmsnorm(x, g):
    xf = x.astype(jnp.float32)
    y = xf * lax.rsqrt(jnp.mean(xf * xf, axis=-1, keepdims=True) + EPS)
    return (y * g.astype(jnp.float32)).astype(x.dtype)


def layernorm(x, g):
    xf = x.astype(jnp.float32)
    xc = xf - jnp.mean(xf, axis=-1, keepdims=True)
    y = xc * lax.rsqrt(jnp.mean(xc * xc, axis=-1, keepdims=True) + EPS)
    return (y * g.astype(jnp.float32)).astype(x.dtype)


def modulate(h, shift, scale):
    return h * (1 + scale) + shift


def split_projection(p):
    o1 = 2 * SGU_WIDTH
    o2 = o1 + S5_WIDTH
    o3 = o2 + 3 * NA_WIDTH
    return p[..., :o1], p[..., o1:o2], p[..., o2:o3], p[..., o3:]


def chunk_sgu(uv, norm_g, w_s, b_s):
    bsz, s, _ = uv.shape
    u, v = jnp.split(jax.nn.gelu(uv), 2, axis=-1)
    v = layernorm(v, norm_g).reshape(bsz, s // SGU_CHUNK, SGU_CHUNK, SGU_GROUPS, SGU_WIDTH // SGU_GROUPS)
    sp = jnp.einsum('gqp,bnpgc->bnqgc', w_s, v) + jnp.transpose(b_s)[None, None, :, :, None]
    return u * sp.reshape(bsz, s, SGU_WIDTH)


def _linear_recurrence(e1, e2):
    a1, b1 = e1
    a2, b2 = e2
    return a1 * a2, a2 * b1 + b2


def s5_scan(xt, lam_bar, b_bar, reverse):
    bu = jnp.einsum('sbgc,gpc->sbgp', xt.astype(jnp.complex64), b_bar)
    a = jnp.broadcast_to(lam_bar, (xt.shape[0], 1) + lam_bar.shape)
    return lax.associative_scan(_linear_recurrence, (a, bu), reverse=reverse, axis=0)


def s5_mix(x_ctx, x_lat, a_re, a_im, log_dt, b_re, b_im, c_re, c_im, d, glu_w, with_ctx_out):
    def to_groups(x):
        t = jnp.moveaxis(x.astype(jnp.float32), 1, 0)
        return t.reshape(t.shape[0], t.shape[1], S5_GROUPS, S5_GROUP)

    xt_c, xt_l = to_groups(x_ctx), to_groups(x_lat)
    dg = d.astype(jnp.float32).reshape(S5_GROUPS, S5_GROUP)
    y_l = dg * xt_l
    y_c = dg * xt_c if with_ctx_out else None
    for direction, reverse in ((0, False), (1, True)):
        lam = lax.complex(a_re[direction].astype(jnp.float32), a_im[direction].astype(jnp.float32))
        dt = jnp.exp(log_dt[direction].astype(jnp.float32))[:, None]
        lam_bar = jnp.exp(lam * dt)
        b_c = lax.complex(b_re[direction].astype(jnp.float32), b_im[direction].astype(jnp.float32))
        b_bar = ((lam_bar - 1) / lam)[:, :, None] * b_c
        c_mat = lax.complex(c_re[direction].astype(jnp.float32), c_im[direction].astype(jnp.float32))
        _, s_c = s5_scan(xt_c, lam_bar, b_bar, reverse)
        s_end = s_c[0] if reverse else s_c[-1]
        a_l, s_l = s5_scan(xt_l, lam_bar, b_bar, reverse)
        s_l = s_l + a_l * s_end[None]
        y_l = y_l + jnp.einsum('sbgp,gcp->sbgc', s_l, c_mat).real
        if with_ctx_out:
            y_c = y_c + jnp.einsum('sbgp,gcp->sbgc', s_c, c_mat).real

    def finish(y, like):
        y = jnp.moveaxis(y.reshape(y.shape[0], y.shape[1], S5_WIDTH), 0, 1)
        y = jax.nn.gelu(y)
        y = y * jax.nn.sigmoid(y @ glu_w.astype(jnp.float32))
        return y.astype(like.dtype)

    y_ctx = finish(y_c, x_ctx) if with_ctx_out else None
    return y_ctx, finish(y_l, x_lat)


def axial_rope(x, rows, cols):
    seg = NA_HEAD_DIM // 2
    inv_freq = ROPE_BASE ** (-jnp.arange(seg // 2, dtype=jnp.float32) / (seg // 2))

    def rotate(xs, pos):
        ang = pos.astype(jnp.float32)[:, None] * inv_freq
        cos = jnp.cos(ang)[None, :, None, :]
        sin = jnp.sin(ang)[None, :, None, :]
        x1, x2 = jnp.split(xs, 2, axis=-1)
        return jnp.concatenate([x1 * cos - x2 * sin, x2 * cos + x1 * sin], axis=-1)

    xf = x.astype(jnp.float32)
    out = jnp.concatenate([rotate(xf[..., :seg], rows), rotate(xf[..., seg:], cols)], axis=-1)
    return out.astype(x.dtype)


def neighbourhood_attention(qkv_ctx, qkv_lat, rpb, with_ctx_out):
    bsz, n_lat, _ = qkv_lat.shape
    n_rows = n_lat // GRID_W
    kr = min(NA_KR, n_rows)
    scale = NA_HEAD_DIM ** -0.5

    def heads(t):
        return t.reshape(t.shape[0], t.shape[1], NA_HEADS, NA_HEAD_DIM)

    q, k, v = (heads(t) for t in jnp.split(qkv_lat, 3, axis=-1))
    qc, kc, vc = (heads(t) for t in jnp.split(qkv_ctx, 3, axis=-1))
    pos = jnp.arange(n_lat)
    q = axial_rope(q, pos // GRID_W, pos % GRID_W)
    k = axial_rope(k, pos // GRID_W, pos % GRID_W)
    grid = (bsz, n_rows, GRID_W, NA_HEADS, NA_HEAD_DIM)
    qg, kg, vg = q.reshape(grid), k.reshape(grid), v.reshape(grid)
    r = jnp.arange(n_rows)
    key_rows = jnp.clip(r - kr // 2, 0, n_rows - kr)[:, None] + jnp.arange(kr)[None, :]
    k_win = kg[:, key_rows]
    v_win = vg[:, key_rows]
    w = jnp.arange(GRID_W)
    col_start = jnp.clip(w - NA_KC // 2, 0, GRID_W - NA_KC)
    col_mask = (w[None, :] >= col_start[:, None]) & (w[None, :] < col_start[:, None] + NA_KC)
    d_row = key_rows - r[:, None] + (NA_KR - 1)
    d_col = jnp.clip(w[None, :] - w[:, None], -(NA_KC - 1), NA_KC - 1) + (NA_KC - 1)
    bias = rpb[:, d_row[:, None, :, None], d_col[None, :, None, :]]
    bias = jnp.moveaxis(bias, 0, 1).astype(jnp.float32)
    s_win = jnp.einsum('brwhd,brjuhd->brhwju', qg, k_win).astype(jnp.float32) * scale + bias[None]
    s_win = jnp.where(col_mask[:, None, :], s_win, NEG_INF)
    s_ctx = jnp.einsum('brwhd,bchd->brhwc', qg, kc).astype(jnp.float32) * scale
    m = jnp.maximum(jnp.max(s_win, axis=(-2, -1)), jnp.max(s_ctx, axis=-1))[..., None]
    e_win = jnp.exp(s_win - m[..., None])
    e_ctx = jnp.exp(s_ctx - m)
    denom = jnp.sum(e_win, axis=(-2, -1)) + jnp.sum(e_ctx, axis=-1)
    p_win = (e_win / denom[..., None, None]).astype(v.dtype)
    p_ctx = (e_ctx / denom[..., None]).astype(v.dtype)
    o = jnp.einsum('brhwju,brjuhd->brwhd', p_win, v_win) + jnp.einsum('brhwc,bchd->brwhd', p_ctx, vc)
    o_lat = o.reshape(bsz, n_lat, NA_WIDTH)
    o_ctx = None
    if with_ctx_out:
        p = jax.nn.softmax(jnp.einsum('bqhd,bkhd->bhqk', qc, kc).astype(jnp.float32) * scale, axis=-1)
        o_ctx = jnp.einsum('bhqk,bkhd->bqhd', p.astype(vc.dtype), vc).reshape(bsz, -1, NA_WIDTH)
    return o_ctx, o_lat


def hier_moe(h, rg_w, rg_b, re_w, re_b, e_gate, e_up, e_down):
    bsz, s, _ = h.shape
    lg = (h @ rg_w + rg_b).astype(jnp.float32)
    pg = jax.nn.softmax(lg, axis=-1)
    grp = jnp.argmax(lg, axis=-1)
    g_weight = jnp.max(pg, axis=-1, keepdims=True)
    g_onehot = jax.nn.one_hot(grp, N_GROUPS, dtype=jnp.float32)
    le = (h @ re_w + re_b).astype(jnp.float32).reshape(bsz, s, N_GROUPS, EXPERTS_PER_GROUP)
    le_sel = jnp.einsum('bsge,bsg->bse', le, g_onehot)
    top_v, top_i = lax.top_k(le_sel, TOP_K)
    top_w = jax.nn.softmax(top_v, axis=-1)
    w_in_group = jnp.sum(jax.nn.one_hot(top_i, EXPERTS_PER_GROUP, dtype=jnp.float32) * top_w[..., None], axis=-2)
    combine = g_weight[..., None] * g_onehot[..., None] * w_in_group[..., None, :]
    combine = combine.reshape(bsz, s, N_EXPERTS).astype(h.dtype)
    out = jnp.zeros_like(h)
    for g in range(N_GROUPS):
        sl = slice(g * EXPERTS_PER_GROUP, (g + 1) * EXPERTS_PER_GROUP)
        hid = jax.nn.silu(jnp.einsum('bsd,edf->bsef', h, e_gate[sl])) * jnp.einsum('bsd,edf->bsef', h, e_up[sl])
        out = out + jnp.einsum('bsef,efd->bsd', hid * combine[..., sl, None], e_down[sl])
    return out


def hybrid_layer(x, xc, mod, mod_c, norm_mix_g, norm_ffn_g, w_in, sgu_norm_g, sgu_w, sgu_b,
                 s5_a_re, s5_a_im, s5_log_dt, s5_b_re, s5_b_im, s5_c_re, s5_c_im, s5_d, s5_glu_w,
                 na_rpb, w_br_a, w_br_b, w_br_c, w_out, rg_w, rg_b, re_w, re_b, e_gate, e_up, e_down,
                 with_ctx_out):
    sh1, sc1, g1, sh2, sc2, g2 = jnp.split(mod[:, None, :], ADA_CHUNKS, axis=-1)
    csh1, csc1, cg1, csh2, csc2, cg2 = jnp.split(mod_c, ADA_CHUNKS, axis=-1)
    h = modulate(rmsnorm(x, norm_mix_g), sh1, sc1)
    hc = modulate(rmsnorm(xc, norm_mix_g), csh1, csc1)
    a_l, b_l, c_l, gate_l = split_projection(h @ w_in)
    a_c, b_c, c_c, gate_c = split_projection(hc @ w_in)
    yb_c, yb_l = s5_mix(b_c, b_l, s5_a_re, s5_a_im, s5_log_dt, s5_b_re, s5_b_im, s5_c_re, s5_c_im,
                        s5_d, s5_glu_w, with_ctx_out)
    yc_c, yc_l = neighbourhood_attention(c_c, c_l, na_rpb, with_ctx_out)

    def merge(ya, yb, yc, gates):
        gt = jax.nn.sigmoid(gates.reshape(gates.shape[:-1] + (N_BRANCH, D_MODEL)))
        m = gt[..., 0, :] * (ya @ w_br_a) + gt[..., 1, :] * (yb @ w_br_b) + gt[..., 2, :] * (yc @ w_br_c)
        return m @ w_out

    x = x + g1 * merge(chunk_sgu(a_l, sgu_norm_g, sgu_w, sgu_b), yb_l, yc_l, gate_l)
    x = x + g2 * hier_moe(modulate(rmsnorm(x, norm_ffn_g), sh2, sc2), rg_w, rg_b, re_w, re_b, e_gate, e_up, e_down)
    if with_ctx_out:
        xc = xc + cg1 * merge(chunk_sgu(a_c, sgu_norm_g, sgu_w, sgu_b), yb_c, yc_c, gate_c)
        xc = xc + cg2 * hier_moe(modulate(rmsnorm(xc, norm_ffn_g), csh2, csc2), rg_w, rg_b, re_w, re_b,
                                 e_gate, e_up, e_down)
    return x, xc


def setup_inputs(seed: int = 0) -> dict:
    key = jax.random.key(seed)
    ks = iter(jax.random.split(key, 48))

    def nrm(shape, scale):
        return scale * jax.random.normal(next(ks), shape, jnp.float32)

    def gain(shape):
        return 1.0 + nrm(shape, 0.02)

    L = DEPTH
    s5_state_shape = (L, 2, S5_GROUPS, S5_STATE)
    a_im_base = jnp.pi * jnp.arange(S5_STATE, dtype=jnp.float32)
    return {
        'x': nrm((BATCH, SEQ, D_MODEL), 1.0),
        'c': nrm((BATCH, D_MODEL), 1.0),
        'ctx': nrm((BATCH, CTX_LEN, D_MODEL), 1.0),
        'c_ctx': nrm((D_MODEL,), 1.0),
        'ada_w': nrm((L, D_MODEL, ADA_CHUNKS * D_MODEL), D_MODEL ** -0.5),
        'ada_b': nrm((L, ADA_CHUNKS * D_MODEL), 0.02),
        'norm_mix_g': gain((L, D_MODEL)),
        'norm_ffn_g': gain((L, D_MODEL)),
        'w_in': nrm((L, D_MODEL, IN_WIDTH), D_MODEL ** -0.5),
        'sgu_norm_g': gain((L, SGU_WIDTH)),
        'sgu_w': nrm((L, SGU_GROUPS, SGU_CHUNK, SGU_CHUNK), SGU_CHUNK ** -0.5),
        'sgu_b': gain((L, SGU_GROUPS, SGU_CHUNK)),
        's5_a_re': -0.5 + nrm(s5_state_shape, 0.01),
        's5_a_im': a_im_base + nrm(s5_state_shape, 0.01),
        's5_log_dt': jax.random.uniform(next(ks), (L, 2, S5_GROUPS), jnp.float32,
                                        math.log(S5_DT_MIN), math.log(S5_DT_MAX)),
        's5_b_re': nrm((L, 2, S5_GROUPS, S5_STATE, S5_GROUP), (2 * S5_GROUP) ** -0.5),
        's5_b_im': nrm((L, 2, S5_GROUPS, S5_STATE, S5_GROUP), (2 * S5_GROUP) ** -0.5),
        's5_c_re': nrm((L, 2, S5_GROUPS, S5_GROUP, S5_STATE), (2 * S5_STATE) ** -0.5),
        's5_c_im': nrm((L, 2, S5_GROUPS, S5_GROUP, S5_STATE), (2 * S5_STATE) ** -0.5),
        's5_d': nrm((L, S5_WIDTH), 1.0),
        's5_glu_w': nrm((L, S5_WIDTH, S5_WIDTH), S5_WIDTH ** -0.5),
        'na_rpb': nrm((L, NA_HEADS, 2 * NA_KR - 1, 2 * NA_KC - 1), 0.02),
        'w_br_a': nrm((L, SGU_WIDTH, D_MODEL), SGU_WIDTH ** -0.5),
        'w_br_b': nrm((L, S5_WIDTH, D_MODEL), S5_WIDTH ** -0.5),
        'w_br_c': nrm((L, NA_WIDTH, D_MODEL), NA_WIDTH ** -0.5),
        'w_out': nrm((L, D_MODEL, D_MODEL), D_MODEL ** -0.5),
        'router_group_w': nrm((L, D_MODEL, N_GROUPS), D_MODEL ** -0.5),
        'router_group_b': nrm((L, N_GROUPS), 0.01),
        'router_expert_w': nrm((L, D_MODEL, N_EXPERTS), D_MODEL ** -0.5),
        'router_expert_b': nrm((L, N_EXPERTS), 0.01),
        'exp_w_gate': nrm((L, N_EXPERTS, D_MODEL, D_EXPERT), D_MODEL ** -0.5),
        'exp_w_up': nrm((L, N_EXPERTS, D_MODEL, D_EXPERT), D_MODEL ** -0.5),
        'exp_w_down': nrm((L, N_EXPERTS, D_EXPERT, D_MODEL), D_EXPERT ** -0.5),
        'final_norm_g': gain((D_MODEL,)),
    }


def reference(x, c, ctx, c_ctx, ada_w, ada_b, norm_mix_g, norm_ffn_g, w_in, sgu_norm_g, sgu_w, sgu_b,
              s5_a_re, s5_a_im, s5_log_dt, s5_b_re, s5_b_im, s5_c_re, s5_c_im, s5_d, s5_glu_w, na_rpb,
              w_br_a, w_br_b, w_br_c, w_out, router_group_w, router_group_b, router_expert_w, router_expert_b,
              exp_w_gate, exp_w_up, exp_w_down, final_norm_g):
    xc = ctx
    silu_c = jax.nn.silu(c)
    silu_cc = jax.nn.silu(c_ctx)
    for l in range(DEPTH):
        mod = silu_c @ ada_w[l] + ada_b[l]
        mod_c = silu_cc @ ada_w[l] + ada_b[l]
        x, xc = hybrid_layer(
            x, xc, mod, mod_c, norm_mix_g[l], norm_ffn_g[l], w_in[l], sgu_norm_g[l], sgu_w[l], sgu_b[l],
            s5_a_re[l], s5_a_im[l], s5_log_dt[l], s5_b_re[l], s5_b_im[l], s5_c_re[l], s5_c_im[l], s5_d[l],
            s5_glu_w[l], na_rpb[l], w_br_a[l], w_br_b[l], w_br_c[l], w_out[l], router_group_w[l],
            router_group_b[l], router_expert_w[l], router_expert_b[l], exp_w_gate[l], exp_w_up[l],
            exp_w_down[l], with_ctx_out=(l < DEPTH - 1))
    return rmsnorm(x, final_norm_g)
```

```cpp
#include <hip/hip_runtime.h>
#include <cstdio>
#include <cstdint>

#define LAS __attribute__((address_space(3)))
typedef unsigned short bf16_t;
typedef short bf16x8 __attribute__((ext_vector_type(8)));
typedef float f32x4 __attribute__((ext_vector_type(4)));
typedef float f32x2 __attribute__((ext_vector_type(2)));
typedef unsigned u32x4 __attribute__((ext_vector_type(4)));
typedef unsigned u32x2 __attribute__((ext_vector_type(2)));

#ifndef N_LAUNCHES
#define N_LAUNCHES 1
#endif
#define PH(k) ((MASK >> (k)) & 1u)
constexpr unsigned ALL_PHASES = 0x3ffffu;

constexpr int DM = 1024, SEQ = 8192, CTXL = 256, NLAT = 32768, NCTX = 1024, NROW = 33792;
constexpr int NWIN = 6144, KCAT = 1408, S5R = 2304, S5RV = 2112, LCAP = 33792;
constexpr float EPSN = 1e-6f;
constexpr int NWAVES = 8, NTHR = 512;

constexpr size_t MiB = 1u << 20;
constexpr size_t WS_CTL = 0, CTL_BYTES = MiB;
constexpr size_t WS_MOD = 1 * MiB;
constexpr size_t WS_ROPE = 1 * MiB + 256 * 1024;
constexpr size_t WS_S5P = 2 * MiB;
constexpr size_t WS_WPL = 6 * MiB, WPL_STRIDE = 27 * MiB;
constexpr size_t WO_WIN = 0, WO_WCAT = 12 * MiB, WO_WOUT = 15 * MiB, WO_WR = 17 * MiB, WO_GLU = 17 * MiB + 512 * 1024, WO_KT = 18 * MiB, WO_WEND = 24 * MiB;
constexpr size_t WS_XC = 60 * MiB;
constexpr size_t WS_Y = 64 * MiB;
constexpr size_t WS_E = 155 * MiB;
constexpr size_t WS_UVG = 182 * MiB;
constexpr size_t WS_QK = 248 * MiB;
constexpr size_t WS_VT = 314 * MiB;
constexpr size_t WS_G = 347 * MiB;
constexpr size_t WS_S5A = 446 * MiB;
constexpr size_t WS_END = 500 * MiB;
constexpr size_t WS_LOGITS = WS_QK, WS_LTOK = WS_QK + 20 * MiB, WS_LW = WS_QK + 30 * MiB;
constexpr size_t WS_HID = WS_G, WS_WGU = WS_G + 42 * MiB, WS_WD = WS_G + 74 * MiB;
constexpr int CW_BAR = 4096, CW_CNT = 1024;

constexpr int LDS_STAGE = 131072, LDS_MISC = 131072, LDS_BYTES = 147456;

__device__ __forceinline__ unsigned f2bf(float f) { unsigned u = __builtin_bit_cast(unsigned, f); return (u + 0x7fffu + ((u >> 16) & 1u)) >> 16; }
__device__ __forceinline__ float bf2f(unsigned b) { return __builtin_bit_cast(float, b << 16); }
__device__ __forceinline__ unsigned cvt_pk_bf16(float lo, float hi) { unsigned r; asm volatile("v_cvt_pk_bf16_f32 %0, %1, %2" : "=v"(r) : "v"(lo), "v"(hi)); return r; }
template <int M> __device__ __forceinline__ float shx(float v, int lane) {
    if constexpr (M < 32) return __builtin_bit_cast(float, __builtin_amdgcn_ds_swizzle(__builtin_bit_cast(int, v), (M << 10) | 0x1f));
    else return __builtin_bit_cast(float, __builtin_amdgcn_ds_bpermute((lane ^ 32) << 2, __builtin_bit_cast(int, v)));
}
__device__ __forceinline__ float wave_sum(float v, int lane) {
    v += shx<1>(v, lane); v += shx<2>(v, lane); v += shx<4>(v, lane); v += shx<8>(v, lane); v += shx<16>(v, lane); v += shx<32>(v, lane);
    return v;
}
__device__ __forceinline__ float gelu_tanh(float x) { const float z2 = 1.5957691216f * (x + 0.044715f * x * x * x); return x * __builtin_amdgcn_rcpf(1.0f + __expf(-z2)); }
__device__ __forceinline__ float sigmoidf_(float x) { return __builtin_amdgcn_rcpf(1.0f + __expf(-x)); }
#define LDS_WAIT() asm volatile("s_waitcnt lgkmcnt(0)" ::: "memory")
template <class T> __device__ __forceinline__ T* opq(T* p) { asm volatile("" : "+s"(p)); return p; }
__device__ __forceinline__ int opq_v(int v) { asm volatile("" : "+v"(v)); return v; }
__device__ __forceinline__ unsigned opq_u(unsigned v) { asm volatile("" : "+v"(v)); return v; }
__device__ __forceinline__ LAS unsigned char* opq_l(LAS unsigned char* p) { unsigned v = (unsigned)(size_t)p; asm volatile("" : "+s"(v)); return (LAS unsigned char*)(size_t)v; }

#define XB_TMO      128
#define XB_XCNT(j)  (256  + 64 * (j))
#define XB_XSUB(j)  (1280 + 64 * (j))
#define XB_XGEN(j)  (2304 + 64 * (j))
#define XB_TOP      3328
#define XB_TOPGEN   3392
#define XCD_BAR_WORDS 3456
#define XB_SPIN_CAP (1u << 18)
__device__ __forceinline__ unsigned xb_ld(unsigned* p)              { return __hip_atomic_load(p, __ATOMIC_RELAXED, __HIP_MEMORY_SCOPE_AGENT); }
__device__ __forceinline__ unsigned xb_add(unsigned* p, unsigned v) { return __hip_atomic_fetch_add(p, v, __ATOMIC_RELAXED, __HIP_MEMORY_SCOPE_AGENT); }
__device__ __forceinline__ unsigned xb_xcc_id() { return (unsigned)__builtin_amdgcn_s_getreg((3 << 11) | 20) & 0xFu; }
#define XB_SPIN(cond, bar) do { unsigned _sp = 0; while (cond) { __builtin_amdgcn_s_sleep(1); \
    if ((++_sp & 255u) == 0u) { if (xb_ld(&(bar)[XB_TMO])) break; if (_sp > XB_SPIN_CAP) { atomicAdd(&(bar)[XB_TMO], 1u); break; } } } } while (0)
struct XcdBarrier { unsigned* bar; unsigned x; volatile LAS unsigned* st; };
__device__ __forceinline__ XcdBarrier xcd_barrier_post(unsigned* bar, volatile LAS unsigned* st) {
    XcdBarrier b; b.bar = bar; b.x = xb_xcc_id(); b.st = st;
    if (threadIdx.x == 0) (void)xb_add(&bar[XB_XCNT(b.x)], 1u);
    return b;
}
__device__ __forceinline__ void xcd_barrier_complete(unsigned* bar, unsigned x, unsigned& nloc, unsigned& nx) {
    const unsigned G = gridDim.x * gridDim.y * gridDim.z;
    unsigned sum, cnt, mine, sp = 0u;
    for (;;) {
        sum = 0u; cnt = 0u; mine = 0u;
#pragma unroll
        for (unsigned j = 0; j < 16; ++j) { const unsigned c = xb_ld(&bar[XB_XCNT(j)]); sum += c; cnt += (c > 0u) ? 1u : 0u; mine = (j == x) ? c : mine; }
        if (sum == G) break;
        __builtin_amdgcn_s_sleep(1);
        if ((++sp & 255u) == 0u) { if (xb_ld(&bar[XB_TMO])) break; if (sp > XB_SPIN_CAP) { atomicAdd(&bar[XB_TMO], 1u); break; } }
    }
    nloc = mine > 0u ? mine : 1u; nx = cnt > 0u ? cnt : 1u;
}
__device__ __forceinline__ void xcd_barrier(const XcdBarrier& b) {
    asm volatile("s_waitcnt vmcnt(0)" ::: "memory");
    __syncthreads();
    if (threadIdx.x == 0) {
        unsigned* bar = b.bar;
        __builtin_amdgcn_s_waitcnt(0);
        unsigned nloc = b.st[0], nx = b.st[1];
        if (nloc == 0u) { xcd_barrier_complete(bar, b.x, nloc, nx); b.st[0] = nloc; b.st[1] = nx; }
        const unsigned old = xb_add(&bar[XB_XSUB(b.x)], 1u);
        const unsigned gen = old / nloc;
        if (old + 1u == (gen + 1u) * nloc) {
            __builtin_amdgcn_fence(__ATOMIC_RELEASE, "agent");
            asm volatile("s_waitcnt vmcnt(0)" ::: "memory");
            const unsigned og = xb_add(&bar[XB_TOP], 1u);
            const unsigned tg = og / nx;
            if (og + 1u == (tg + 1u) * nx) xb_add(&bar[XB_TOPGEN], 1u);
            else XB_SPIN(xb_ld(&bar[XB_TOPGEN]) == tg, bar);
            __builtin_amdgcn_fence(__ATOMIC_ACQUIRE, "agent");
            xb_add(&bar[XB_XGEN(b.x)], 1u);
            asm volatile("s_waitcnt vmcnt(0)" ::: "memory");
        } else {
            XB_SPIN(xb_ld(&bar[XB_XGEN(b.x)]) == gen, bar);
            __builtin_amdgcn_fence(__ATOMIC_ACQUIRE, "agent");
            asm volatile("s_waitcnt vmcnt(0)" ::: "memory");
        }
    }
    __syncthreads();
}

namespace g8 {
constexpr int BM = 256, BK = 64, HALF = 128, HTB = HALF * BK * 2, NXCD = 8, WGM = 8;
__device__ __forceinline__ int lds_byte(int r, int c) { const int st = (r >> 4) * 2 + (c >> 5), rr = r & 15, cc = c & 31, ob = rr * 64 + cc * 2; return st * 1024 + (ob ^ (((ob >> 9) & 1) << 5)); }
__device__ __forceinline__ void stage_rc(int b, int& R, int& C) { const int st = b / 1024, sb = b % 1024, swz = sb ^ (((sb >> 9) & 1) << 5); R = (st >> 1) * 16 + swz / 64; C = (st & 1) * 32 + (swz % 64) / 2; }
__device__ __forceinline__ int perm32(int rho) { const int n = rho >> 4, i = rho & 15; return 8 * (i >> 2) + 4 * n + (i & 3); }

struct GUnit { int pm, pn; unsigned a, b; int x, y; };

struct SchedDense {
    static constexpr bool GATHER = false;
    const char* A; const char* B; unsigned tsA, tsB; int nM, nN, nwg, G, c;
    __device__ __forceinline__ void init(const void* A_, const void* B_, int M, int N, int lda, int ldb, int G_, int c_) {
        A = (const char*)A_; B = (const char*)B_; nM = M / BM; nN = N / BM; nwg = nM * nN; G = G_; c = c_; tsA = (unsigned)(BM * lda * 2); tsB = (unsigned)(BM * ldb * 2); }
    __device__ __forceinline__ bool next(int i, GUnit& u) const {
        const long L = (long)i * G + c; if (L >= nwg) return false;
        int wgid = (int)L; { const int q = nwg / NXCD, r = nwg % NXCD, xcd = wgid % NXCD, off = wgid / NXCD; wgid = (xcd < r ? xcd * (q + 1) : r * (q + 1) + (xcd - r) * q) + off; }
        const int nig = WGM * nN, gid = wgid / nig, fm = gid * WGM, gsz = (nM - fm) < WGM ? (nM - fm) : WGM;
        u.pm = fm + ((wgid % nig) % gsz); u.pn = (wgid % nig) / gsz; u.a = (unsigned)u.pm * tsA; u.b = (unsigned)u.pn * tsB; u.x = 0; u.y = 0; return true;
    }
    __device__ __forceinline__ unsigned arow(const GUnit&, int) const { return 0u; }
};
struct SchedS5 {
    static constexpr bool GATHER = false;
    const char* A; const char* B; unsigned bstride; int G, c;
    __device__ __forceinline__ bool next(int i, GUnit& u) const {
        const int L = i * G + c; if (L >= 24 * 9) return false;
        const int g = L / 9, tl = L % 9; u.pm = tl; u.pn = 0; u.x = g; u.y = 0;
        u.a = (unsigned)((g * S5R + 256 * tl) * 512) * 2u; u.b = (unsigned)g * bstride; return true;
    }
    __device__ __forceinline__ unsigned arow(const GUnit&, int) const { return 0u; }
};
struct SchedMoeUp {
    static constexpr bool GATHER = true;
    const char* A; const char* B; const int* ltok; const LAS int* tstart; const LAS int* cnt; int G, c;
    __device__ __forceinline__ bool next(int i, GUnit& u) const {
        const int L = i * G + c; const int T = L >> 1; if (T >= tstart[64]) return false;
        int q = 0;
#pragma unroll 1
        for (int j = 1; j < 64; ++j) q += (tstart[j] <= T) ? 1 : 0;
        u.pm = T; u.pn = L & 1; u.x = q; u.y = T - tstart[q]; u.a = 0u; u.b = (unsigned)(((q & 31) * 512 + (L & 1) * 256) * 1024) * 2u; return true;
    }
    __device__ __forceinline__ unsigned arow(const GUnit& u, int R) const {
        const int idx = 256 * u.y + R; const int tok = idx < cnt[u.x] ? ltok[(size_t)u.x * LCAP + idx] : 0; return (unsigned)tok * 2048u; }
};
struct SchedMoeDown {
    static constexpr bool GATHER = false;
    const char* A; const char* B; const LAS int* tstart; int rank, G, c;
    __device__ __forceinline__ bool next(int i, GUnit& u) const {
        const int L = i * G + c; const int T = tstart[32 * rank] + (L >> 2); if (T >= tstart[32 * rank + 32]) return false;
        int q = 0;
#pragma unroll 1
        for (int j = 1; j < 64; ++j) q += (tstart[j] <= T) ? 1 : 0;
        u.pm = T; u.pn = L & 3; u.x = q; u.y = T - tstart[q]; u.a = (unsigned)(T * 256 * 256) * 2u; u.b = (unsigned)(((q & 31) * 1024 + (L & 3) * 256) * 256) * 2u; return true;
    }
    __device__ __forceinline__ unsigned arow(const GUnit&, int) const { return 0u; }
};

template <class Epi, class Sched>
__device__ __forceinline__ void gemm_run(LAS unsigned char* lds, const int K, const int lda, const int ldb, const Sched& S, const Epi& E) {
    const int tid = opq_v((int)threadIdx.x), wid = __builtin_amdgcn_readfirstlane(tid >> 6), lane = tid & 63, wr = wid >> 2, wc = wid & 3, fr = lane & 15, fq = lane >> 4;
    const int nt = K / BK;
    constexpr int NH = Sched::GATHER ? 2 : 1;
    unsigned voffB[2], vAc[NH][2];
#pragma unroll
    for (int i = 0; i < 2; ++i) { int R, C; stage_rc(tid * 16 + i * 8192, R, C); const int Rb = Epi::PERM ? ((R & ~31) + perm32(R & 31)) : R;
        voffB[i] = (unsigned)(Rb * ldb + C) * 2u; }
    constexpr unsigned kstep = BK * 2;
    const unsigned hstepB = (unsigned)(HALF * ldb * 2);
    const unsigned hstepA = Sched::GATHER ? 0u : (unsigned)(HALF * lda * 2);
    const char* const baseA = S.A; const char* const baseB = S.B;
    const unsigned ldsw = (unsigned)wid * 1024u;
    const int aoff = lds_byte(wr * 64 + fr, fq * 8), boff = lds_byte(wc * 32 + fr, fq * 8);
#define G8_SA(b, h) (((b) * 2 + (h)) * HTB)
#define G8_SB(b, h) ((4 + (b) * 2 + (h)) * HTB)
#define G8_STAGE_A(bufoff, gbase, VA, h) do { _Pragma("unroll") for (int _i = 0; _i < 2; ++_i) \
        __builtin_amdgcn_global_load_lds((const unsigned*)(baseA + ((gbase) + (h) * hstepA) + opq_u((VA)[(h) * (NH - 1)][_i])), (LAS unsigned*)(lds + (bufoff) + ldsw + _i * 8192), 16, 0, 0); } while (0)
#define G8_STAGE_B(bufoff, gbase) do { _Pragma("unroll") for (int _i = 0; _i < 2; ++_i) \
        __builtin_amdgcn_global_load_lds((const unsigned*)(baseB + (gbase) + opq_u(voffB[_i])), (LAS unsigned*)(lds + (bufoff) + ldsw + _i * 8192), 16, 0, 0); } while (0)
#define G8_LDA(dst, b, h) do { _Pragma("unroll") for (int m = 0; m < 4; ++m) _Pragma("unroll") for (int k = 0; k < 2; ++k) dst[m][k] = *(const LAS bf16x8*)(lds + G8_SA(b, h) + aoff + m * 2048 + k * 1024); } while (0)
#define G8_LDB(dst, b, h) do { _Pragma("unroll") for (int n = 0; n < 2; ++n) _Pragma("unroll") for (int k = 0; k < 2; ++k) dst[n][k] = *(const LAS bf16x8*)(lds + G8_SB(b, h) + boff + n * 2048 + k * 1024); } while (0)
#define G8_MMA(ai, bj, At, Bt) do { __builtin_amdgcn_s_setprio(1); _Pragma("unroll") for (int m = 0; m < 4; ++m) _Pragma("unroll") for (int n = 0; n < 2; ++n) _Pragma("unroll") for (int k = 0; k < 2; ++k) \
        acc[ai][bj][m][n] = __builtin_amdgcn_mfma_f32_16x16x32_bf16(Bt[n][k], At[m][k], acc[ai][bj][m][n], 0, 0, 0); __builtin_amdgcn_s_setprio(0); } while (0)
#define G8_WAIT_V(n) asm volatile("s_waitcnt vmcnt(" #n ")" ::: "memory")
#define G8_WAIT_L(n) asm volatile("s_waitcnt lgkmcnt(" #n ")" ::: "memory")
#define G8_BAR __builtin_amdgcn_s_barrier()
#define G8_SCHED __builtin_amdgcn_sched_barrier(0)
#define G8_KPAIR_A(a1) do { \
            G8_LDB(B0, 0, 0); G8_LDB(B1, 0, 1); G8_SCHED; G8_LDA(At, 0, 0); G8_STAGE_A(G8_SA(1, 1), (a1), vAc, 1); \
            G8_WAIT_V(8); G8_WAIT_L(0); G8_BAR; G8_MMA(0, 0, At, B0); G8_MMA(0, 1, At, B1); G8_BAR; G8_SCHED; } while (0)
#define G8_KPAIR_B(a2, b2, VA2) do { \
            G8_LDA(At, 0, 1); G8_STAGE_B(G8_SB(0, 0), (b2)); G8_STAGE_B(G8_SB(0, 1), (b2) + hstepB); G8_STAGE_A(G8_SA(0, 0), (a2), VA2, 0); \
            G8_WAIT_V(8); G8_WAIT_L(0); G8_BAR; G8_MMA(1, 0, At, B0); G8_MMA(1, 1, At, B1); G8_BAR; G8_SCHED; \
            G8_LDB(B0, 1, 0); G8_LDB(B1, 1, 1); G8_SCHED; G8_LDA(At, 1, 0); G8_STAGE_A(G8_SA(0, 1), (a2), VA2, 1); \
            G8_WAIT_V(8); G8_WAIT_L(0); G8_BAR; G8_MMA(0, 0, At, B0); G8_MMA(0, 1, At, B1); G8_BAR; G8_SCHED; \
            G8_LDA(At, 1, 1); G8_STAGE_B(G8_SB(1, 0), (b2) + kstep); G8_STAGE_B(G8_SB(1, 1), (b2) + kstep + hstepB); G8_STAGE_A(G8_SA(1, 0), (a2) + kstep, VA2, 0); \
            G8_WAIT_V(8); G8_WAIT_L(0); G8_BAR; G8_MMA(1, 0, At, B0); G8_MMA(1, 1, At, B1); G8_BAR; G8_SCHED; } while (0)
#define G8_KPAIR(a1, a2, b2, VA2) do { G8_KPAIR_A(a1); G8_KPAIR_B(a2, b2, VA2); } while (0)
    GUnit cur, nxt; int ui = 0;
    if (!S.next(0, cur)) return;
    f32x4 acc[2][2][4][2];
#pragma unroll
    for (int a = 0; a < 2; ++a)
#pragma unroll
        for (int b = 0; b < 2; ++b)
#pragma unroll
            for (int m = 0; m < 4; ++m)
#pragma unroll
                for (int n = 0; n < 2; ++n) acc[a][b][m][n] = (f32x4){0.f, 0.f, 0.f, 0.f};
    bf16x8 At[4][2], B0[2][2], B1[2][2];
#pragma unroll
    for (int h = 0; h < NH; ++h)
#pragma unroll
        for (int i = 0; i < 2; ++i) { int R, C; stage_rc(tid * 16 + i * 8192, R, C);
            if constexpr (Sched::GATHER) vAc[h][i] = S.arow(cur, R + HALF * h) + (unsigned)C * 2u;
            else vAc[h][i] = (unsigned)(R * lda + C) * 2u; }
    unsigned cA = cur.a, cB = cur.b;
    G8_STAGE_B(G8_SB(0, 0), cB); G8_STAGE_B(G8_SB(0, 1), cB + hstepB); G8_STAGE_A(G8_SA(0, 0), cA, vAc, 0); G8_STAGE_A(G8_SA(0, 1), cA, vAc, 1);
    if (wr == 1) G8_BAR;
    G8_WAIT_V(2); G8_BAR;
    G8_STAGE_B(G8_SB(1, 0), cB + kstep); G8_STAGE_A(G8_SA(1, 0), cA + kstep, vAc, 0); G8_STAGE_B(G8_SB(1, 1), cB + kstep + hstepB);
    G8_WAIT_V(6); G8_BAR;
    for (;;) {
        const bool has_next = S.next(ui + 1, nxt);
        const unsigned nA = has_next ? nxt.a : cA, nB = has_next ? nxt.b : cB;
        for (int t = 0; t < nt - 2; t += 2) { const unsigned a1 = cA + (unsigned)(t + 1) * kstep, a2 = cA + (unsigned)(t + 2) * kstep, b2 = cB + (unsigned)(t + 2) * kstep; G8_KPAIR(a1, a2, b2, vAc); }
        {
            const unsigned a1 = cA + (unsigned)(nt - 1) * kstep;
            if constexpr (Sched::GATHER) {
                G8_KPAIR_A(a1);
                if (has_next) {
#pragma unroll
                    for (int h = 0; h < 2; ++h)
#pragma unroll
                        for (int i = 0; i < 2; ++i) { int R, C; stage_rc(tid * 16 + i * 8192, R, C); vAc[h][i] = S.arow(nxt, R + HALF * h) + (unsigned)C * 2u; }
                }
                G8_KPAIR_B(nA, nB, vAc);
            } else {
                G8_KPAIR(a1, nA, nB, vAc);
            }
        }
        if (wr == 0) G8_BAR;
        E(acc, cur, wr, wc, opq_v(fr), opq_v(fq));
        if (!has_next) break;
#pragma unroll
        for (int a = 0; a < 2; ++a)
#pragma unroll
            for (int b = 0; b < 2; ++b)
#pragma unroll
                for (int m = 0; m < 4; ++m)
#pragma unroll
                    for (int n = 0; n < 2; ++n) acc[a][b][m][n] = (f32x4){0.f, 0.f, 0.f, 0.f};
        cur = nxt; cA = nA; cB = nB; ++ui;
        if (wr == 1) G8_BAR;
    }
    G8_WAIT_V(0);
    G8_BAR;
#undef G8_SA
#undef G8_SB
#undef G8_STAGE_A
#undef G8_STAGE_B
#undef G8_LDA
#undef G8_LDB
#undef G8_MMA
#undef G8_WAIT_V
#undef G8_WAIT_L
#undef G8_BAR
#undef G8_SCHED
#undef G8_KPAIR
#undef G8_KPAIR_A
#undef G8_KPAIR_B
}

typedef f32x4 Acc[2][2][4][2];

__device__ __forceinline__ u32x4 pack8(const f32x4 v0, const f32x4 v1) { u32x4 w; w.x = cvt_pk_bf16(v0[0], v0[1]); w.y = cvt_pk_bf16(v0[2], v0[3]); w.z = cvt_pk_bf16(v1[0], v1[1]); w.w = cvt_pk_bf16(v1[2], v1[3]); return w; }

struct EpiWin {
    static constexpr bool PERM = true;
    unsigned char* wsb;
    __device__ __forceinline__ void operator()(Acc& acc, const GUnit& u, int wr, int wc, int fr, int fq) const {
        bf16_t* const uvg = (bf16_t*)(wsb + WS_UVG); bf16_t* const qk = (bf16_t*)(wsb + WS_QK); bf16_t* const vt = (bf16_t*)(wsb + WS_VT); bf16_t* const vtc = (bf16_t*)(wsb + WS_VT + 32 * MiB);
        unsigned char* const gates = wsb + WS_G; bf16_t* const s5a = (bf16_t*)(wsb + WS_S5A); const float* const ropec = (const float*)(wsb + WS_ROPE); const float* const ropes = ropec + 128 * 16;
        const int pn = u.pn, row0 = u.pm * 256 + wr * 64 + fr, cl = wc * 32 + 8 * fq;
        if (pn < 4) {
#pragma unroll
            for (int ai = 0; ai < 2; ++ai)
#pragma unroll
                for (int m = 0; m < 4; ++m) { bf16_t* rp = uvg + (size_t)(row0 + ai * 128 + m * 16) * 1024 + pn * 256 + cl;
#pragma unroll
                    for (int bj = 0; bj < 2; ++bj) { f32x4 v0 = acc[ai][bj][m][0], v1 = acc[ai][bj][m][1];
#pragma unroll
                        for (int j = 0; j < 4; ++j) { v0[j] = gelu_tanh(v0[j]); v1[j] = gelu_tanh(v1[j]); }
                        *(u32x4*)(rp + bj * 128) = pack8(v0, v1); } }
        } else if (pn < 8) {
            const float sc = pn < 6 ? 0.125f : 1.0f; const bool lat = u.pm < 128; const int seg = wc & 1, f0 = 8 * (fq & 1); const float sg = fq < 2 ? -1.f : 1.f;
#pragma unroll
            for (int ai = 0; ai < 2; ++ai) { const int grow = (4 * u.pm + 2 * ai + wr) & 127;
#pragma unroll
                for (int m = 0; m < 4; ++m) { bf16_t* rp = qk + (size_t)(row0 + ai * 128 + m * 16) * 1024 + (pn - 4) * 256 + cl;
                    const int pos = seg ? (16 * m + fr) : grow;
                    f32x4 c0 = {1.f, 1.f, 1.f, 1.f}, c1 = c0, s0 = {0.f, 0.f, 0.f, 0.f}, s1 = s0;
                    if (lat) { c0 = *(const f32x4*)(ropec + pos * 16 + f0); c1 = *(const f32x4*)(ropec + pos * 16 + f0 + 4); s0 = *(const f32x4*)(ropes + pos * 16 + f0); s1 = *(const f32x4*)(ropes + pos * 16 + f0 + 4); }
#pragma unroll
                    for (int bj = 0; bj < 2; ++bj) { f32x4 v0 = acc[ai][bj][m][0], v1 = acc[ai][bj][m][1], o0, o1;
#pragma unroll
                        for (int j = 0; j < 4; ++j) { const float x0 = shx<32>(v0[j], fr + 16 * fq), x1 = shx<32>(v1[j], fr + 16 * fq);
                            o0[j] = (v0[j] * c0[j] + sg * x0 * s0[j]) * sc; o1[j] = (v1[j] * c1[j] + sg * x1 * s1[j]) * sc; }
                        *(u32x4*)(rp + bj * 128) = pack8(o0, o1); } } }
        } else if (pn < 10) {
#pragma unroll
            for (int ai = 0; ai < 2; ++ai)
#pragma unroll
                for (int m = 0; m < 4; ++m) { const int row = row0 + ai * 128 + m * 16; bf16_t* bp; size_t stride;
                    if (row < NLAT) { bp = vt + (size_t)((row >> 13) * 512) * 8192 + (row & 8191); stride = 8192; }
                    else { const int rr = row - NLAT; bp = vtc + (size_t)((rr >> 8) * 512) * 256 + (rr & 255); stride = 256; }
#pragma unroll
                    for (int bj = 0; bj < 2; ++bj) { const int c = (pn - 8) * 256 + bj * 128 + cl;
#pragma unroll
                        for (int n = 0; n < 2; ++n)
#pragma unroll
                            for (int j = 0; j < 4; ++j) bp[(size_t)(c + 4 * n + j) * stride] = (bf16_t)f2bf(acc[ai][bj][m][n][j]); } }
        } else if (pn < 22) {
#pragma unroll
            for (int ai = 0; ai < 2; ++ai)
#pragma unroll
                for (int m = 0; m < 4; ++m) { unsigned char* rp = gates + (size_t)(row0 + ai * 128 + m * 16) * 3072 + (pn - 10) * 256 + cl;
#pragma unroll
                    for (int bj = 0; bj < 2; ++bj) { u32x2 w;
#pragma unroll
                        for (int n = 0; n < 2; ++n) { unsigned pk = 0;
#pragma unroll
                            for (int j = 0; j < 4; ++j) { float q = __builtin_rintf(sigmoidf_(acc[ai][bj][m][n][j]) * 255.0f); q = fminf(fmaxf(q, 1.0f), 255.0f); pk |= ((unsigned)q) << (8 * j); }
                            w[n] = pk; }
                        *(u32x2*)(rp + bj * 128) = w; } }
        } else {
#pragma unroll
            for (int bj = 0; bj < 2; ++bj) { const int ch = (pn - 22) * 256 + bj * 128 + cl;
                if (ch < 384) { const int g = ch >> 4, c0 = ch & 15;
#pragma unroll
                    for (int ai = 0; ai < 2; ++ai)
#pragma unroll
                        for (int m = 0; m < 4; ++m) { const int row = row0 + ai * 128 + m * 16;
                            *(u32x4*)(s5a + ((size_t)(g * S5R + (row >> 4)) * 512) + (row & 15) * 16 + c0) = pack8(acc[ai][bj][m][0], acc[ai][bj][m][1]); } } }
        }
    }
};

struct EpiMerge {
    static constexpr bool PERM = true;
    const unsigned char* gates; bf16_t* mb; int j;
    __device__ __forceinline__ void operator()(Acc& acc, const GUnit& u, int wr, int wc, int fr, int fq) const {
        const int row0 = u.pm * 256 + wr * 64 + fr, col = u.pn * 256 + wc * 32 + 8 * fq;
#pragma unroll
        for (int ai = 0; ai < 2; ++ai)
#pragma unroll
            for (int m = 0; m < 4; ++m) { const size_t row = (size_t)(row0 + ai * 128 + m * 16); const unsigned char* rp = gates + row * 3072 + 1024 * j + col;
#pragma unroll
                for (int bj = 0; bj < 2; ++bj) { const u32x2 gc = *(const u32x2*)(rp + bj * 128); bf16_t* mp = mb + row * 1024 + col + bj * 128; f32x4 v0, v1;
                    u32x4 pv = {0u, 0u, 0u, 0u}; if (j > 0) pv = *(const u32x4*)mp;
#pragma unroll
                    for (int k = 0; k < 4; ++k) { v0[k] = acc[ai][bj][m][0][k] * ((float)((gc[0] >> (8 * k)) & 255u) * (1.0f / 255.0f)); v1[k] = acc[ai][bj][m][1][k] * ((float)((gc[1] >> (8 * k)) & 255u) * (1.0f / 255.0f)); }
#pragma unroll
                    for (int k = 0; k < 2; ++k) { v0[2 * k] += bf2f(pv[k] & 0xffffu); v0[2 * k + 1] += bf2f(pv[k] >> 16); v1[2 * k] += bf2f(pv[2 + k] & 0xffffu); v1[2 * k + 1] += bf2f(pv[2 + k] >> 16); }
                    *(u32x4*)mp = pack8(v0, v1); }
                asm volatile("" ::: "memory"); }
    }
};

struct EpiWout {
    static constexpr bool PERM = false;
    const float* old_lat; const float* old_ctx; float* new_lat; float* new_ctx; const float* modl;
    __device__ __forceinline__ void operator()(Acc& acc, const GUnit& u, int wr, int wc, int fr, int fq) const {
        const bool lat = u.pm < 128; const int mrow = lat ? (u.pm >> 5) : 4;
        const float* gp = modl + mrow * 6144 + 2048; const int col0 = u.pn * 256 + wc * 32 + 4 * fq;
        const int rbase = (lat ? u.pm * 256 : (u.pm - 128) * 256) + wr * 64 + fr;
        const float* op = lat ? old_lat : old_ctx; float* np = lat ? new_lat : new_ctx;
        f32x4 gv[2][2];
#pragma unroll
        for (int bj = 0; bj < 2; ++bj)
#pragma unroll
            for (int n = 0; n < 2; ++n) gv[bj][n] = *(const f32x4*)(gp + col0 + bj * 128 + n * 16);
#pragma unroll
        for (int ai = 0; ai < 2; ++ai)
#pragma unroll
            for (int m = 0; m < 4; ++m) { const size_t off = (size_t)(rbase + ai * 128 + m * 16) * 1024 + col0;
#pragma unroll
                for (int bj = 0; bj < 2; ++bj)
#pragma unroll
                    for (int n = 0; n < 2; ++n) { const f32x4 xo = *(const f32x4*)(op + off + bj * 128 + n * 16); *(f32x4*)(np + off + bj * 128 + n * 16) = xo + gv[bj][n] * acc[ai][bj][m][n]; }
                asm volatile("" ::: "memory"); }
    }
};

struct EpiLogits {
    static constexpr bool PERM = false;
    float* lg;
    __device__ __forceinline__ void operator()(Acc& acc, const GUnit& u, int wr, int wc, int fr, int fq) const {
        const int row0 = u.pm * 256 + wr * 64 + fr, col0 = wc * 32 + 4 * fq;
#pragma unroll
        for (int ai = 0; ai < 2; ++ai)
#pragma unroll
            for (int m = 0; m < 4; ++m) { float* rp = lg + (size_t)(row0 + ai * 128 + m * 16) * 128 + col0;
#pragma unroll
                for (int n = 0; n < 2; ++n) *(f32x4*)(rp + n * 16) = acc[ai][0][m][n]; }
    }
};

struct EpiS5E {
    static constexpr bool PERM = true;
    bf16_t* e;
    __device__ __forceinline__ void operator()(Acc& acc, const GUnit& u, int wr, int wc, int fr, int fq) const {
        const int R0 = u.pm * 256 + wr * 64 + fr, cl = wc * 32 + 8 * fq;
#pragma unroll
        for (int ai = 0; ai < 2; ++ai)
#pragma unroll
            for (int m = 0; m < 4; ++m) { bf16_t* rp = e + ((size_t)(u.x * S5R + R0 + ai * 128 + m * 16) * 256) + cl;
#pragma unroll
                for (int bj = 0; bj < 2; ++bj) *(u32x4*)(rp + bj * 128) = pack8(acc[ai][bj][m][0], acc[ai][bj][m][1]); }
    }
};

struct EpiS5Y {
    static constexpr bool PERM = true;
    bf16_t* yg;
    __device__ __forceinline__ void operator()(Acc& acc, const GUnit& u, int wr, int wc, int fr, int fq) const {
        const int R0 = u.pm * 256 + wr * 64 + fr, cl = wc * 32 + 8 * fq;
#pragma unroll
        for (int ai = 0; ai < 2; ++ai)
#pragma unroll
            for (int m = 0; m < 4; ++m) { const int R = R0 + ai * 128 + m * 16;
                if (R < S5RV) {
#pragma unroll
                    for (int bj = 0; bj < 2; ++bj) { const int col8 = bj * 128 + cl, i = col8 >> 4, co0 = col8 & 15; f32x4 v0 = acc[ai][bj][m][0], v1 = acc[ai][bj][m][1];
#pragma unroll
                        for (int j = 0; j < 4; ++j) { v0[j] = gelu_tanh(v0[j]); v1[j] = gelu_tanh(v1[j]); }
                        *(u32x4*)(yg + (size_t)(16 * R + i) * 384 + 16 * u.x + co0) = pack8(v0, v1); } } }
    }
};

struct EpiGlu {
    static constexpr bool PERM = true;
    const bf16_t* yg; bf16_t* ycat;
    __device__ __forceinline__ void operator()(Acc& acc, const GUnit& u, int wr, int wc, int fr, int fq) const {
        const int row0 = u.pm * 256 + wr * 64 + fr, col0 = u.pn * 256 + wc * 32 + 8 * fq;
#pragma unroll
        for (int ai = 0; ai < 2; ++ai)
#pragma unroll
            for (int m = 0; m < 4; ++m) { const size_t row = (size_t)(row0 + ai * 128 + m * 16);
#pragma unroll
                for (int bj = 0; bj < 2; ++bj) {
                    if (u.pn == 0 || bj == 0) { const int col = col0 + bj * 128;
                        const u32x4 y = *(const u32x4*)(yg + row * 384 + col); f32x4 v0, v1;
#pragma unroll
                        for (int j = 0; j < 2; ++j) { v0[2 * j] = bf2f(y[j] & 0xffffu) * sigmoidf_(acc[ai][bj][m][0][2 * j]); v0[2 * j + 1] = bf2f(y[j] >> 16) * sigmoidf_(acc[ai][bj][m][0][2 * j + 1]);
                            v1[2 * j] = bf2f(y[2 + j] & 0xffffu) * sigmoidf_(acc[ai][bj][m][1][2 * j]); v1[2 * j + 1] = bf2f(y[2 + j] >> 16) * sigmoidf_(acc[ai][bj][m][1][2 * j + 1]); }
                        *(u32x4*)(ycat + row * KCAT + 512 + col) = pack8(v0, v1); } }
                asm volatile("" ::: "memory"); }
    }
};

struct EpiMoeUp {
    static constexpr bool PERM = true;
    bf16_t* hid; const float* lw; const LAS int* cnt;
    __device__ __forceinline__ void operator()(Acc& acc, const GUnit& u, int wr, int wc, int fr, int fq) const {
        const int rit0 = wr * 64 + fr, cl = wc * 32 + 8 * fq; const int n_l = cnt[u.x];
#pragma unroll
        for (int ai = 0; ai < 2; ++ai)
#pragma unroll
            for (int m = 0; m < 4; ++m) { const int rit = rit0 + ai * 128 + m * 16, idx = 256 * u.y + rit;
                const float cw = idx < n_l ? lw[(size_t)u.x * LCAP + idx] : 0.f; f32x4 v0, v1;
#pragma unroll
                for (int j = 0; j < 4; ++j) { const float g0 = acc[ai][0][m][0][j], g1 = acc[ai][0][m][1][j];
                    v0[j] = g0 * sigmoidf_(g0) * acc[ai][1][m][0][j] * cw; v1[j] = g1 * sigmoidf_(g1) * acc[ai][1][m][1][j] * cw; }
                *(u32x4*)(hid + ((size_t)(256 * u.pm + rit) * 256) + 128 * u.pn + cl) = pack8(v0, v1); }
    }
};

struct EpiMoeDown {
    static constexpr bool PERM = false;
    float* xlat; float* xc; const float* modl; const int* ltok; const LAS int* cnt;
    __device__ __forceinline__ void operator()(Acc& acc, const GUnit& u, int wr, int wc, int fr, int fq) const {
        const int rit0 = wr * 64 + fr, col0 = u.pn * 256 + wc * 32 + 4 * fq; const int n_l = cnt[u.x];
#pragma unroll
        for (int ai = 0; ai < 2; ++ai)
#pragma unroll
            for (int m = 0; m < 4; ++m) { const int rit = rit0 + ai * 128 + m * 16, idx = 256 * u.y + rit;
                if (idx < n_l) { const int tok = ltok[(size_t)u.x * LCAP + idx]; const bool lat = tok < NLAT;
                    float* xp = lat ? xlat + (size_t)tok * 1024 : xc + (size_t)(tok - NLAT) * 1024; const float* gp = modl + (lat ? (tok >> 13) : 4) * 6144 + 5120;
#pragma unroll
                    for (int bj = 0; bj < 2; ++bj)
#pragma unroll
                        for (int n = 0; n < 2; ++n) { const int c = col0 + bj * 128 + n * 16; const f32x4 gv = *(const f32x4*)(gp + c); const f32x4 xo = *(const f32x4*)(xp + c); *(f32x4*)(xp + c) = xo + gv * acc[ai][bj][m][n]; } }
                asm volatile("" ::: "memory"); }
    }
};
}

struct Params { const float* in[34]; float* out; unsigned char* ws; };

__device__ __forceinline__ void tr_item(const float* src, int ldsrc, int ksrc0, int nsrc0, bf16_t* dst, int lddst, int ndst0, int kdst0, LAS float* scr, int lane) {
#pragma unroll 8
    for (int i = 0; i < 32; ++i) { const int kk = 2 * i + (lane >> 5); scr[kk * 33 + (lane & 31)] = src ? src[(size_t)(ksrc0 + kk) * ldsrc + nsrc0 + (lane & 31)] : 0.f; }
    LDS_WAIT(); asm volatile("" ::: "memory");
    const int c = lane & 7;
#pragma unroll
    for (int j = 0; j < 4; ++j) { const int n = (lane >> 3) + 8 * j; const LAS float* s = scr + (8 * c) * 33 + n;
        u32x4 o; o.x = f2bf(s[0]) | (f2bf(s[33]) << 16); o.y = f2bf(s[66]) | (f2bf(s[99]) << 16); o.z = f2bf(s[132]) | (f2bf(s[165]) << 16); o.w = f2bf(s[198]) | (f2bf(s[231]) << 16);
        *(u32x4*)(dst + (size_t)(ndst0 + n) * lddst + kdst0 + 8 * c) = o; }
    LDS_WAIT(); asm volatile("" ::: "memory");
}

__device__ __forceinline__ void norm_mod_row(const float* xrow, const float* gain, const float* shift, const float* scale, bf16_t* orow, int lane) {
    const f32x4* xr = (const f32x4*)xrow + lane; f32x4 v[4]; float s = 0.f;
#pragma unroll
    for (int j = 0; j < 4; ++j) { v[j] = xr[64 * j]; s += (v[j].x * v[j].x + v[j].y * v[j].y) + (v[j].z * v[j].z + v[j].w * v[j].w); }
    const float r = 1.0f / sqrtf(wave_sum(s, lane) * (1.0f / DM) + EPSN);
#pragma unroll
    for (int j = 0; j < 4; ++j) { const int c = 4 * lane + 256 * j; const f32x4 g = *(const f32x4*)(gain + c), sh = *(const f32x4*)(shift + c), sc = *(const f32x4*)(scale + c);
        const f32x4 h = (v[j] * r * g) * (sc + 1.0f) + sh;
        u32x2 o; o.x = cvt_pk_bf16(h.x, h.y); o.y = cvt_pk_bf16(h.z, h.w); *(u32x2*)(orow + c) = o; }
}

template <bool LATENT>
__device__ __forceinline__ void attn_tile(const bf16_t* qk, const bf16_t* vt, const bf16_t* vtc, bf16_t* ycat, const LAS float* rpbh, int b, int h, int qrow0, int r, int wt, int lane) {
    const int qi = lane & 15, g = lane >> 4;
    const bf16_t* qp = qk + (size_t)(qrow0 + qi) * 1024 + h * 64 + 8 * g;
    const bf16x8 qf0 = *(const bf16x8*)qp, qf1 = *(const bf16x8*)(qp + 32);
    float m_run = -1e30f, l_run = 0.f; f32x4 o[4];
#pragma unroll
    for (int d = 0; d < 4; ++d) o[d] = (f32x4){0.f, 0.f, 0.f, 0.f};
    const f32x4 z4 = {0.f, 0.f, 0.f, 0.f};
#define ATT_STEP(S0, S1, VB, VSTRIDE) do { \
        float cm = fmaxf(fmaxf(fmaxf(S0[0], S0[1]), fmaxf(S0[2], S0[3])), fmaxf(fmaxf(S1[0], S1[1]), fmaxf(S1[2], S1[3]))); \
        cm = fmaxf(cm, shx<16>(cm, lane)); cm = fmaxf(cm, shx<32>(cm, lane)); \
        const float mn = fmaxf(m_run, cm), al = __expf(m_run - mn); m_run = mn; \
        f32x4 p0, p1; float ps = 0.f; \
        _Pragma("unroll") for (int j = 0; j < 4; ++j) { p0[j] = __expf(S0[j] - mn); p1[j] = __expf(S1[j] - mn); ps += p0[j] + p1[j]; } \
        l_run = l_run * al + ps; \
        union { u32x4 u; bf16x8 v; } pb; pb.u = g8::pack8(p0, p1); \
        _Pragma("unroll") for (int db = 0; db < 4; ++db) { const bf16_t* vp = (VB) + (size_t)(16 * db + qi) * (VSTRIDE); \
            union { u32x4 u; bf16x8 v; } va; const u32x2 lo = *(const u32x2*)vp, hi = *(const u32x2*)(vp + 16); va.u.x = lo.x; va.u.y = lo.y; va.u.z = hi.x; va.u.w = hi.y; \
            o[db] = o[db] * al; o[db] = __builtin_amdgcn_mfma_f32_16x16x32_bf16(va.v, pb.v, o[db], 0, 0, 0); } } while (0)
    if (LATENT) {
        const int kr0 = min(max(r - 4, 0), 120); const int c0 = (wt == 0) ? 0 : (wt == 1 ? 8 : (wt == 2 ? 24 : 32));
        const int wq = 16 * wt + qi, cs = min(max(wq - 8, 0), 48);
#pragma unroll 2
        for (int jr = 0; jr < 8; ++jr) {
            const int kr = kr0 + jr, s0 = kr * 64 + c0;
            const bf16_t* kp = qk + (size_t)(b * 8192 + s0 + qi) * 1024 + 512 + h * 64 + 8 * g;
            const bf16x8 k00 = *(const bf16x8*)kp, k01 = *(const bf16x8*)(kp + 32), k10 = *(const bf16x8*)(kp + 16 * 1024), k11 = *(const bf16x8*)(kp + 16 * 1024 + 32);
            f32x4 sa = __builtin_amdgcn_mfma_f32_16x16x32_bf16(k00, qf0, z4, 0, 0, 0); sa = __builtin_amdgcn_mfma_f32_16x16x32_bf16(k01, qf1, sa, 0, 0, 0);
            f32x4 sb = __builtin_amdgcn_mfma_f32_16x16x32_bf16(k10, qf0, z4, 0, 0, 0); sb = __builtin_amdgcn_mfma_f32_16x16x32_bf16(k11, qf1, sb, 0, 0, 0);
            const LAS float* bp = rpbh + (kr - r + 7) * 31;
#pragma unroll
            for (int j = 0; j < 4; ++j) { const int wk = c0 + 4 * g + j; const int wk2 = wk + 16;
                const bool v0 = (wk >= cs) && (wk < cs + 16), v1 = (wk2 >= cs) && (wk2 < cs + 16);
                const int i0 = min(max(wk - wq + 15, 0), 30), i1 = min(max(wk2 - wq + 15, 0), 30);
                sa[j] = v0 ? sa[j] + bp[i0] : -1e30f; sb[j] = v1 ? sb[j] + bp[i1] : -1e30f; }
            const bf16_t* vb = vt + (size_t)((b * 8 + h) * 64) * 8192 + s0 + 4 * g;
            ATT_STEP(sa, sb, vb, 8192);
        }
    }
#pragma unroll 2
    for (int ch = 0; ch < 8; ++ch) {
        const int j0 = 32 * ch;
        const bf16_t* kp = qk + (size_t)(NLAT + b * 256 + j0 + qi) * 1024 + 512 + h * 64 + 8 * g;
        const bf16x8 k00 = *(const bf16x8*)kp, k01 = *(const bf16x8*)(kp + 32), k10 = *(const bf16x8*)(kp + 16 * 1024), k11 = *(const bf16x8*)(kp + 16 * 1024 + 32);
        f32x4 sa = __builtin_amdgcn_mfma_f32_16x16x32_bf16(k00, qf0, z4, 0, 0, 0); sa = __builtin_amdgcn_mfma_f32_16x16x32_bf16(k01, qf1, sa, 0, 0, 0);
        f32x4 sb = __builtin_amdgcn_mfma_f32_16x16x32_bf16(k10, qf0, z4, 0, 0, 0); sb = __builtin_amdgcn_mfma_f32_16x16x32_bf16(k11, qf1, sb, 0, 0, 0);
        const bf16_t* vb = vtc + (size_t)((b * 8 + h) * 64) * 256 + j0 + 4 * g;
        ATT_STEP(sa, sb, vb, 256);
    }
#undef ATT_STEP
    float l = l_run; l += shx<16>(l, lane); l += shx<32>(l, lane);
    const float inv = 1.0f / l;
    bf16_t* op = ycat + (size_t)(qrow0 + qi) * KCAT + 896 + h * 64 + 4 * g;
#pragma unroll
    for (int db = 0; db < 4; ++db) { u32x2 w; w.x = cvt_pk_bf16(o[db][0] * inv, o[db][1] * inv); w.y = cvt_pk_bf16(o[db][2] * inv, o[db][3] * inv); *(u32x2*)(op + 16 * db) = w; }
}

typedef const __attribute__((address_space(4))) char* KargPtr;
#define INP(i) (*(const float* const volatile __attribute__((address_space(4)))*)(karg + 8 * (i)))
#define WSP(off) (opq(ws) + (off))
#define ctl ((unsigned*)WSP(WS_CTL))
#define mod ((float*)WSP(WS_MOD))
#define ropec ((float*)WSP(WS_ROPE))
#define ropes ((float*)WSP(WS_ROPE + 128 * 16 * 4))
#define s5p ((f32x2*)WSP(WS_S5P))
#define xc ((float*)WSP(WS_XC))
#define ycat ((bf16_t*)WSP(WS_Y))
#define hbuf ycat
#define h2 ycat
#define ebuf ((bf16_t*)WSP(WS_E))
#define ygelu ebuf
#define uvg ((bf16_t*)WSP(WS_UVG))
#define mbuf uvg
#define qk ((bf16_t*)WSP(WS_QK))
#define vt ((bf16_t*)WSP(WS_VT))
#define vtc ((bf16_t*)WSP(WS_VT + 32 * MiB))
#define gates (WSP(WS_G))
#define s5a ((bf16_t*)WSP(WS_S5A))
#define logits ((float*)WSP(WS_LOGITS))
#define ltok ((int*)WSP(WS_LTOK))
#define lw ((float*)WSP(WS_LW))
#define hid ((bf16_t*)WSP(WS_HID))
#define wgu ((bf16_t*)WSP(WS_WGU))
#define wdt ((bf16_t*)WSP(WS_WD))
#define xout (opq(xout_raw))

#define PHASE_IDS() const int lane = opq_v((int)__builtin_amdgcn_mbcnt_hi(~0u, __builtin_amdgcn_mbcnt_lo(~0u, 0u))); int wave_ = wave0; asm volatile("" : "+s"(wave_)); const int wave = wave_, tid = wave * 64 + lane; \
    const int gw = bid * NWAVES + wave; LAS unsigned char* lds = opq_l(lds0); (void)tid; (void)gw; (void)lds
#define GRID_BAR() do { if constexpr (MULTI) { XcdBarrier b_; b_.bar = (unsigned*)WSP(WS_CTL) + CW_BAR + bli * XCD_BAR_WORDS; b_.x = xb_xcc_id(); b_.st = (volatile LAS unsigned*)(opq_l(lds0) + LDS_MISC); xcd_barrier(b_); } } while (0)
template <unsigned MASK>
__device__ __forceinline__ void layer_body(const int l, KargPtr karg, unsigned char* ws, float* xout_raw, LAS unsigned char* const lds0, const int wave0, const int G, const int bid, const int NGW, const int bli) {
    constexpr bool MULTI = (MASK & (MASK - 1u)) != 0u;
    const int MROWS = (l == 0) ? NROW : NLAT;
#define wb (WSP(WS_WPL) + (size_t)l * WPL_STRIDE)
#define modl (mod + l * 5 * 6144)
        if (PH(2)) { PHASE_IDS(); const float* xl_ = (l == 0 ? INP(0) : (const float*)xout); const float* xc_ = (l == 0 ? INP(2) : (const float*)xc); const float* gn_ = INP(6) + l * 1024; bf16_t* hb_ = hbuf;
          for (int r = gw; r < NROW; r += NGW) {
            const bool lat = r < NLAT; const float* xr = lat ? (xl_ + (size_t)r * 1024) : (xc_ + (size_t)(r - NLAT) * 1024);
            const float* mr = modl + (lat ? (r >> 13) : 4) * 6144;
            norm_mod_row(xr, gn_, mr, mr + 1024, hb_ + (size_t)r * 1024, lane);
          } }
        GRID_BAR();
        if (PH(3)) { PHASE_IDS();
            g8::SchedDense S; S.init(hbuf, wb + WO_WIN, NROW, NWIN, 1024, 1024, G, bid);
            g8::EpiWin E{WSP(0)};
            g8::gemm_run(lds, 1024, 1024, 1024, S, E);
        }
        GRID_BAR();
        if (PH(4)) { PHASE_IDS();
            g8::SchedS5 S{(const char*)s5a, (const char*)(wb + WO_WEND), 256u * 256u * 2u, G, bid};
            g8::EpiS5E E{ebuf};
            g8::gemm_run(lds, 256, 512, 256, S, E);
        }
        if (PH(5)) { PHASE_IDS();
            const int nunits = (l == 0 ? 264 : 256) * 4;
            LAS bf16_t* vnT = (LAS bf16_t*)lds;
            const float* sw = INP(10) + (size_t)l * 4 * 128 * 128; const float* sbias = INP(11) + l * 4 * 128; const float* sgam = INP(9) + l * 512;
            for (int unit = bid; unit < nunits; unit += G) {
                const int ch = unit >> 2, g = unit & 3; const int r0 = 128 * ch;
                {
                    const int p = tid >> 2, qd = tid & 3; const bf16_t* vp = uvg + (size_t)(r0 + p) * 1024 + 512 + 128 * qd; float s = 0.f, s2 = 0.f;
#pragma unroll 4
                    for (int i = 0; i < 16; ++i) { const u32x4 w = *(const u32x4*)(vp + 8 * i);
#pragma unroll
                        for (int j = 0; j < 4; ++j) { const float a = bf2f(w[j] & 0xffffu), b = bf2f(w[j] >> 16); s += a + b; s2 += a * a + b * b; } }
                    s += shx<1>(s, lane); s += shx<2>(s, lane); s2 += shx<1>(s2, lane); s2 += shx<2>(s2, lane);
                    const float mean = s * (1.0f / 512.0f); const float var = fmaxf(s2 * (1.0f / 512.0f) - mean * mean, 0.f); const float rstd = 1.0f / sqrtf(var + EPSN);
                    const bf16_t* gp = uvg + (size_t)(r0 + p) * 1024 + 512 + 128 * g + 32 * qd;
#pragma unroll
                    for (int i = 0; i < 4; ++i) { const u32x4 w = *(const u32x4*)(gp + 8 * i);
#pragma unroll
                        for (int j = 0; j < 4; ++j) { const int c = 32 * qd + 8 * i + 2 * j;
                            vnT[c * 136 + p] = (bf16_t)f2bf((bf2f(w[j] & 0xffffu) - mean) * rstd * sgam[128 * g + c]);
                            vnT[(c + 1) * 136 + p] = (bf16_t)f2bf((bf2f(w[j] >> 16) - mean) * rstd * sgam[128 * g + c + 1]); } }
                }
                __syncthreads();
                {
                    const int qi = lane & 15, gq = lane >> 4; const int q = 16 * wave + qi;
                    bf16x8 wf[4];
#pragma unroll
                    for (int kk = 0; kk < 4; ++kk) { const float* wp = sw + ((size_t)g * 128 + q) * 128 + 32 * kk + 8 * gq; const f32x4 a = *(const f32x4*)wp, b = *(const f32x4*)(wp + 4);
                        union { u32x4 u; bf16x8 v; } t; t.u = g8::pack8(a, b); wf[kk] = t.v; }
                    const float bq = sbias[g * 128 + q];
                    const bf16_t* up = uvg + (size_t)(r0 + q) * 1024 + 128 * g; bf16_t* op = ycat + (size_t)(r0 + q) * KCAT + 128 * g;
#pragma unroll 2
                    for (int cb = 0; cb < 8; ++cb) { f32x4 d = {0.f, 0.f, 0.f, 0.f};
#pragma unroll
                        for (int kk = 0; kk < 4; ++kk) { const bf16x8 af = *(const LAS bf16x8*)(vnT + (16 * cb + qi) * 136 + 32 * kk + 8 * gq); d = __builtin_amdgcn_mfma_f32_16x16x32_bf16(af, wf[kk], d, 0, 0, 0); }
                        const int c = 16 * cb + 4 * gq; const u32x2 uu = *(const u32x2*)(up + c); u32x2 w;
                        w.x = cvt_pk_bf16(bf2f(uu.x & 0xffffu) * (d[0] + bq), bf2f(uu.x >> 16) * (d[1] + bq)); w.y = cvt_pk_bf16(bf2f(uu.y & 0xffffu) * (d[2] + bq), bf2f(uu.y >> 16) * (d[3] + bq));
                        *(u32x2*)(op + c) = w; }
                }
                __syncthreads();
            }
        }
        GRID_BAR();
        if (PH(6)) { PHASE_IDS();
            LAS float* rpbS = (LAS float*)lds;
            { const float* rp_ = INP(21) + (size_t)l * 8 * 465; for (int i = tid; i < 8 * 465; i += NTHR) rpbS[i] = rp_[i]; }
            __syncthreads();
            if (wave == 0 && bid < 192) {
                const int b = bid / 48, g = (bid % 48) >> 1, dir = bid & 1;
                const f32x2 lam16 = s5p[(size_t)((l * 2 + dir) * 24 + g) * 3136 + 16 * 64 + lane];
                float cr = 0.f, ci = 0.f;
                const bf16_t* eb = ebuf + (size_t)g * S5R * 256 + dir * 128 + lane; bf16_t* cb = s5a + (size_t)g * S5R * 512 + 256 + dir * 128 + lane;
                for (int k0 = 0; k0 < 528; k0 += 16) {
                    unsigned short er[16], ei[16];
#pragma unroll
                    for (int j = 0; j < 16; ++j) { const int k = k0 + j; const int R = (k < 16) ? (2048 + 16 * b + (dir ? 15 - k : k)) : (512 * b + (dir ? 527 - k : k - 16));
                        er[j] = eb[(size_t)R * 256]; ei[j] = eb[(size_t)R * 256 + 64]; }
#pragma unroll
                    for (int j = 0; j < 16; ++j) { const int k = k0 + j; const int R = (k < 16) ? (2048 + 16 * b + (dir ? 15 - k : k)) : (512 * b + (dir ? 527 - k : k - 16));
                        cb[(size_t)R * 512] = (bf16_t)f2bf(cr); cb[(size_t)R * 512 + 64] = (bf16_t)f2bf(ci);
                        const float nr = lam16.x * cr - lam16.y * ci + bf2f(er[j]), ni = lam16.x * ci + lam16.y * cr + bf2f(ei[j]); cr = nr; ci = ni; }
                }
            }
            const int nun = 16384 + (l == 0 ? 512 : 0);
            for (int un = gw; un < nun; un += NGW) {
                if (un < 16384) { const int wt = un & 3, h = (un >> 2) & 7, r = (un >> 5) & 127, b = un >> 12;
                    attn_tile<true>(qk, vt, vtc, ycat, rpbS + h * 465, b, h, b * 8192 + r * 64 + 16 * wt, r, wt, lane); }
                else { const int u2 = un - 16384, qt = u2 & 15, h = (u2 >> 4) & 7, b = u2 >> 7;
                    attn_tile<false>(qk, vt, vtc, ycat, rpbS, b, h, NLAT + b * 256 + 16 * qt, 0, 0, lane); }
            }
        }
        GRID_BAR();
        if (PH(7)) { PHASE_IDS();
            g8::SchedS5 S{(const char*)s5a, (const char*)(wb + WO_KT), 256u * 512u * 2u, G, bid};
            g8::EpiS5Y E{ygelu};
            g8::gemm_run(lds, 512, 512, 512, S, E);
        }
        GRID_BAR();
        if (PH(8)) { PHASE_IDS();
            g8::SchedDense S; S.init(ygelu, wb + WO_GLU, MROWS, 512, 384, 384, G, bid);
            g8::EpiGlu E{ygelu, ycat};
            g8::gemm_run(lds, 384, 384, 384, S, E);
        }
        GRID_BAR();
        if (PH(9)) { PHASE_IDS();
            { g8::SchedDense S; S.init(ycat, wb + WO_WCAT, MROWS, 1024, KCAT, KCAT, G, bid); g8::EpiMerge E{gates, mbuf, 0}; g8::gemm_run(lds, 512, KCAT, KCAT, S, E); }
            { g8::SchedDense S; S.init(ycat + 512, wb + WO_WCAT + 512 * 2, MROWS, 1024, KCAT, KCAT, G, bid); g8::EpiMerge E{gates, mbuf, 1}; g8::gemm_run(lds, 384, KCAT, KCAT, S, E); }
            { g8::SchedDense S; S.init(ycat + 896, wb + WO_WCAT + 896 * 2, MROWS, 1024, KCAT, KCAT, G, bid); g8::EpiMerge E{gates, mbuf, 2}; g8::gemm_run(lds, 512, KCAT, KCAT, S, E); }
        }
        GRID_BAR();
        if (PH(10)) { PHASE_IDS();
            g8::SchedDense S; S.init(mbuf, wb + WO_WOUT, MROWS, 1024, 1024, 1024, G, bid);
            g8::EpiWout E{l == 0 ? INP(0) : (const float*)xout, l == 0 ? INP(2) : (const float*)xc, xout, xc, modl};
            g8::gemm_run(lds, 1024, 1024, 1024, S, E);
        }
        GRID_BAR();
        if (PH(11)) { PHASE_IDS(); const float* xl_ = xout; const float* xc_ = xc; const float* gn_ = INP(7) + l * 1024; bf16_t* hb_ = h2;
          for (int r = gw; r < MROWS; r += NGW) {
            const bool lat = r < NLAT; const float* xr = lat ? (xl_ + (size_t)r * 1024) : (xc_ + (size_t)(r - NLAT) * 1024);
            const float* mr = modl + (lat ? (r >> 13) : 4) * 6144;
            norm_mod_row(xr, gn_, mr + 3072, mr + 4096, hb_ + (size_t)r * 1024, lane);
          } }
        if (PH(11)) { PHASE_IDS();
            LAS float* scr = (LAS float*)(lds + wave * 8448);
            for (int it = gw; it < 32 * 384; it += NGW) { const int e = it / 384; int r = it % 384;
                if (r < 256) { const int up = r >> 7; r &= 127; const int kb = r >> 3, nb = r & 7, n0 = 32 * nb;
                    tr_item((up ? INP(31) : INP(30)) + ((size_t)(l * 32 + e) * 1024) * 256, 256, 64 * kb, n0, wgu + (size_t)e * 512 * 1024, 1024, 256 * (n0 >> 7) + 128 * up + (n0 & 127), 64 * kb, scr, lane); }
                else { r -= 256; const int kb = r >> 5, nb = r & 31; tr_item(INP(32) + ((size_t)(l * 32 + e) * 256) * 1024, 1024, 64 * kb, 32 * nb, wdt + (size_t)e * 1024 * 256, 256, 32 * nb, 64 * kb, scr, lane); }
            }
        }
        GRID_BAR();
        if (PH(12)) { PHASE_IDS();
            g8::SchedDense S; S.init(h2, wb + WO_WR, MROWS, 256, 1024, 1024, G, bid);
            g8::EpiLogits E{logits};
            g8::gemm_run(lds, 1024, 1024, 1024, S, E);
        }
        GRID_BAR();
        if (PH(13)) { PHASE_IDS();
            unsigned* cntg = ctl + CW_CNT + l * 64; const float* rgb = INP(27) + l * 4; const float* reb = INP(29) + l * 32; const float* lg_ = logits; int* lt_ = ltok; float* lw_ = lw;
            for (int r = bid * NTHR + tid; r < MROWS; r += G * NTHR) {
                const float* lp = lg_ + (size_t)r * 128; float v[72];
#pragma unroll
                for (int i = 0; i < 18; ++i) { const f32x4 t = *(const f32x4*)(lp + 4 * i); v[4 * i] = t.x; v[4 * i + 1] = t.y; v[4 * i + 2] = t.z; v[4 * i + 3] = t.w; }
                float lg[4]; int grp = 0; float gmax;
#pragma unroll
                for (int j = 0; j < 4; ++j) lg[j] = v[j] + v[36 + j] + rgb[j];
                gmax = lg[0];
#pragma unroll
                for (int j = 1; j < 4; ++j) if (lg[j] > gmax) { gmax = lg[j]; grp = j; }
                float gs = 0.f;
#pragma unroll
                for (int j = 0; j < 4; ++j) gs += __expf(lg[j] - gmax);
                const float gwt = 1.0f / gs;
                float le[8];
#pragma unroll
                for (int j = 0; j < 8; ++j) { float a = 0.f;
#pragma unroll
                    for (int q = 0; q < 4; ++q) a = (grp == q) ? (v[4 + 8 * q + j] + v[40 + 8 * q + j]) : a;
                    le[j] = a + reb[8 * grp + j]; }
                int i1 = 0; float v1 = le[0];
#pragma unroll
                for (int j = 1; j < 8; ++j) if (le[j] > v1) { v1 = le[j]; i1 = j; }
                int i2 = -1; float v2 = -3.4e38f;
#pragma unroll
                for (int j = 0; j < 8; ++j) if (j != i1 && le[j] > v2) { v2 = le[j]; i2 = j; }
                const float e2 = __expf(v2 - v1); const float w1 = 1.0f / (1.0f + e2), w2 = e2 * w1;
                const int L0 = 8 * grp + i1, L1 = 32 + 8 * grp + i2;
                const unsigned s0 = atomicAdd(cntg + L0, 1u), s1 = atomicAdd(cntg + L1, 1u);
                lt_[(size_t)L0 * LCAP + s0] = r; lw_[(size_t)L0 * LCAP + s0] = gwt * w1;
                lt_[(size_t)L1 * LCAP + s1] = r; lw_[(size_t)L1 * LCAP + s1] = gwt * w2;
            }
        }
        GRID_BAR();
#define MOE_TABLES() LAS int* tstart = (LAS int*)(lds + LDS_MISC) + 16; LAS int* lcnt = (LAS int*)(lds + LDS_MISC) + 96; \
            if (tid < 64) lcnt[tid] = (int)__hip_atomic_load(ctl + CW_CNT + l * 64 + tid, __ATOMIC_RELAXED, __HIP_MEMORY_SCOPE_AGENT); \
            __syncthreads(); \
            if (tid == 0) { int s = 0; for (int j = 0; j < 64; ++j) { tstart[j] = s; s += (lcnt[j] + 255) >> 8; } tstart[64] = s; } \
            __syncthreads()
        if (PH(14)) { PHASE_IDS(); MOE_TABLES();
            g8::SchedMoeUp S{(const char*)h2, (const char*)wgu, ltok, tstart, lcnt, G, bid};
            g8::EpiMoeUp E{hid, lw, lcnt};
            g8::gemm_run(lds, 1024, 1024, 1024, S, E);
        }
        GRID_BAR();
        if (PH(15)) { PHASE_IDS(); MOE_TABLES();
            g8::SchedMoeDown S{(const char*)hid, (const char*)wdt, tstart, 0, G, bid};
            g8::EpiMoeDown E{xout, xc, mod + l * 5 * 6144, ltok, lcnt};
            g8::gemm_run(lds, 256, 256, 256, S, E);
        }
        GRID_BAR();
        if (PH(16)) { PHASE_IDS(); MOE_TABLES();
            g8::SchedMoeDown S{(const char*)hid, (const char*)wdt, tstart, 1, G, bid};
            g8::EpiMoeDown E{xout, xc, mod + l * 5 * 6144, ltok, lcnt};
            g8::gemm_run(lds, 256, 256, 256, S, E);
        }
        GRID_BAR();
}

template <unsigned MASK>
__global__ void __launch_bounds__(NTHR, 2) hybrid_fwd(Params P, int l0, int l1, int bli) {
    constexpr bool MULTI = (MASK & (MASK - 1u)) != 0u;
    extern __shared__ __attribute__((aligned(16))) unsigned char lds_raw[];
    LAS unsigned char* const lds0 = (LAS unsigned char*)lds_raw; LAS unsigned char* lds = lds0;
    volatile LAS unsigned* MISC = (volatile LAS unsigned*)(lds + LDS_MISC);
    const int tid = threadIdx.x, lane = tid & 63, wave = __builtin_amdgcn_readfirstlane(tid >> 6);
    const int G = gridDim.x, bid = blockIdx.x;
    const int gw = bid * NWAVES + wave, NGW = G * NWAVES;
    KargPtr karg = (KargPtr)__builtin_amdgcn_kernarg_segment_ptr();
    unsigned char* ws = *(unsigned char* const volatile __attribute__((address_space(4)))*)(karg + 8 * 35);
    for (int u = tid; u < 256; u += NTHR) MISC[u] = 0u;
    __syncthreads();
    if constexpr (MULTI) (void)xcd_barrier_post((unsigned*)(ws + WS_CTL) + CW_BAR + bli * XCD_BAR_WORDS, MISC);
    const int wave0 = wave;

    float* xout_raw = *(float* const volatile __attribute__((address_space(4)))*)(karg + 8 * 34);

    if (PH(0)) {
        LAS float* scr = (LAS float*)(lds + wave * 8448);
        constexpr int IT_WIN = 16 * 192, IT_A = 8 * 32, IT_B = 6 * 32, IT_C = 8 * 32, IT_O = 16 * 32, IT_G = 6 * 16, IT_L = IT_WIN + IT_A + IT_B + IT_C + IT_O + IT_G;
        for (int it = gw; it < 2 * IT_L; it += NGW) {
            const int l = it / IT_L; int r = it % IT_L; unsigned char* wbp = ws + WS_WPL + (size_t)l * WPL_STRIDE;
            if (r < IT_WIN) { const int kb = r / 192, nb = r % 192, n0 = 32 * nb; int src = -1;
                if (n0 < 1024) src = n0; else if (n0 < 2560) src = 1408 + (n0 - 1024); else if (n0 < 5632) src = 2944 + (n0 - 2560); else if (n0 < 6016) src = 1024 + (n0 - 5632);
                tr_item(src >= 0 ? INP(8) + (size_t)l * 1024 * 6016 : nullptr, 6016, 64 * kb, src, (bf16_t*)(wbp + WO_WIN), 1024, n0, 64 * kb, scr, lane); continue; } r -= IT_WIN;
            if (r < IT_A) { tr_item(INP(22) + (size_t)l * 512 * 1024, 1024, 64 * (r / 32), 32 * (r % 32), (bf16_t*)(wbp + WO_WCAT), KCAT, 32 * (r % 32), 64 * (r / 32), scr, lane); continue; } r -= IT_A;
            if (r < IT_B) { tr_item(INP(23) + (size_t)l * 384 * 1024, 1024, 64 * (r / 32), 32 * (r % 32), (bf16_t*)(wbp + WO_WCAT), KCAT, 32 * (r % 32), 512 + 64 * (r / 32), scr, lane); continue; } r -= IT_B;
            if (r < IT_C) { tr_item(INP(24) + (size_t)l * 512 * 1024, 1024, 64 * (r / 32), 32 * (r % 32), (bf16_t*)(wbp + WO_WCAT), KCAT, 32 * (r % 32), 896 + 64 * (r / 32), scr, lane); continue; } r -= IT_C;
            if (r < IT_O) { tr_item(INP(25) + (size_t)l * 1024 * 1024, 1024, 64 * (r / 32), 32 * (r % 32), (bf16_t*)(wbp + WO_WOUT), 1024, 32 * (r % 32), 64 * (r / 32), scr, lane); continue; } r -= IT_O;
            { const int kb = r / 16, nb = r % 16; tr_item(nb < 12 ? INP(20) + (size_t)l * 384 * 384 : nullptr, 384, 64 * kb, 32 * nb, (bf16_t*)(wbp + WO_GLU), 384, 32 * nb, 64 * kb, scr, lane); }
        }
        const float* rgw = INP(26); const float* rew = INP(28);
        for (int idx = bid * NTHR + tid; idx < 2 * 256 * 1024; idx += G * NTHR) {
            const int l = idx >> 18, n = (idx >> 10) & 255, k = idx & 1023; float w = 0.f; int lo = 0, j = n;
            if (n >= 36 && n < 72) { lo = 1; j = n - 36; }
            if (n < 72) w = j < 4 ? rgw[(size_t)l * 1024 * 4 + k * 4 + j] : rew[(size_t)l * 1024 * 32 + k * 32 + (j - 4)];
            const unsigned hb = f2bf(w); const float res = lo ? (w - bf2f(hb)) : 0.f;
            ((bf16_t*)(ws + WS_WPL + (size_t)l * WPL_STRIDE + WO_WR))[n * 1024 + k] = (bf16_t)(lo ? f2bf(res) : hb);
        }
        for (int idx = bid * NTHR + tid; idx < 128 * 16; idx += G * NTHR) {
            const int pos = idx >> 4, f = idx & 15; const float inv = powf(10000.0f, -(float)f / 16.0f); const float ang = (float)pos * inv;
            ropec[idx] = cosf(ang); ropes[idx] = sinf(ang);
        }
        const float* s5bre = INP(15); const float* s5bim = INP(16); const float* s5cre = INP(17); const float* s5cim = INP(18);
        for (int idx = bid * NTHR + tid; idx < 2 * 2 * 24 * 64; idx += G * NTHR) {
            const int p = idx & 63, ldg = idx >> 6;
            const float are = INP(12)[idx], aim = INP(13)[idx]; const float dt = expf(INP(14)[ldg]);
            const float zr = are * dt, zi = aim * dt;
            f32x2* base = s5p + (size_t)ldg * 3136;
            for (int d = 0; d <= 16; ++d) { const float e = expf(zr * (float)d); base[d * 64 + p] = (f32x2){e * cosf(zi * (float)d), e * sinf(zi * (float)d)}; }
            const float e1 = expf(zr), lr = e1 * cosf(zi) - 1.0f, li = e1 * sinf(zi); const float den = 1.0f / (are * are + aim * aim);
            const float cr = (lr * are + li * aim) * den, ci = (li * are - lr * aim) * den;
            for (int c = 0; c < 16; ++c) { const float br = s5bre[(size_t)idx * 16 + c], bi = s5bim[(size_t)idx * 16 + c];
                base[1088 + p * 16 + c] = (f32x2){cr * br - ci * bi, cr * bi + ci * br};
                base[2112 + c * 64 + p] = (f32x2){s5cre[((size_t)ldg * 16 + c) * 64 + p], s5cim[((size_t)ldg * 16 + c) * 64 + p]}; }
        }
        __syncthreads();
        for (int unit = bid; unit < 2 * 96; unit += G) {
            const int l = unit / 96, n0 = 64 * (unit % 96);
            LAS float* sv = (LAS float*)lds; LAS float* part = sv + 5 * 1024;
            const float* cv = INP(1); const float* ccv = INP(3);
            for (int i = tid; i < 5 * 1024; i += NTHR) { const int m = i >> 10, k = i & 1023; const float c = m < 4 ? cv[m * 1024 + k] : ccv[k]; sv[i] = c * sigmoidf_(c); }
            __syncthreads();
            float a[5] = {0.f, 0.f, 0.f, 0.f, 0.f};
            const float* wp = INP(4) + (size_t)l * 1024 * 6144 + n0 + lane;
#pragma unroll 4
            for (int k = wave * 128; k < wave * 128 + 128; ++k) { const float w = wp[(size_t)k * 6144];
#pragma unroll
                for (int m = 0; m < 5; ++m) a[m] += sv[m * 1024 + k] * w; }
#pragma unroll
            for (int m = 0; m < 5; ++m) part[(wave * 5 + m) * 64 + lane] = a[m];
            __syncthreads();
            if (tid < 320) { const int m = tid >> 6, n = tid & 63; float s = 0.f;
#pragma unroll
                for (int w = 0; w < 8; ++w) s += part[(w * 5 + m) * 64 + n];
                mod[(l * 5 + m) * 6144 + n0 + n] = s + INP(5)[l * 6144 + n0 + n]; }
            __syncthreads();
        }
    }
    GRID_BAR();
    if (PH(1)) for (int unit = bid; unit < 48; unit += G) {
        const int l = unit / 24, g = unit % 24;
        LAS float* Gt = (LAS float*)lds;
        const f32x2* pf = s5p + (size_t)((l * 2 + 0) * 24 + g) * 3136; const f32x2* pr = s5p + (size_t)((l * 2 + 1) * 24 + g) * 3136;
        for (int e = tid; e < 8192; e += NTHR) { const int dir = e >> 12, d = (e >> 8) & 15, co = (e >> 4) & 15, ci = e & 15; const f32x2* pp = dir ? pr : pf; float s = 0.f;
            for (int p = 0; p < 64; ++p) { const f32x2 c = pp[2112 + co * 64 + p], w = pp[d * 64 + p], bb = pp[1088 + p * 16 + ci];
                const float tr = c.x * w.x - c.y * w.y, ti = c.x * w.y + c.y * w.x; s += tr * bb.x - ti * bb.y; }
            Gt[e] = s; }
        __syncthreads();
        bf16_t* kt = (bf16_t*)(ws + WS_WPL + (size_t)l * WPL_STRIDE + WO_KT) + (size_t)g * 256 * 512;
        bf16_t* we = (bf16_t*)(ws + WS_WPL + (size_t)l * WPL_STRIDE + WO_WEND) + (size_t)g * 256 * 256;
        const float* s5d = INP(19) + l * 384 + 16 * g;
        for (int idx = tid; idx < 256 * 512; idx += NTHR) { const int n = idx >> 9, k = idx & 511, m = n >> 4, co = n & 15; float v = 0.f;
            if (k < 256) { const int mp = k >> 4, ci = k & 15;
                if (mp <= m) v += Gt[((m - mp) * 16 + co) * 16 + ci];
                if (mp >= m) v += Gt[4096 + ((mp - m) * 16 + co) * 16 + ci];
                if (mp == m && co == ci) v += s5d[co];
            } else { const int q = (k - 256) & 127, dir = (k - 256) >> 7, p = q & 63, im = q >> 6; const f32x2* pp = dir ? pr : pf;
                const f32x2 c = pp[2112 + co * 64 + p], w = pp[(dir ? (16 - m) : (m + 1)) * 64 + p];
                v = im ? -(c.x * w.y + c.y * w.x) : (c.x * w.x - c.y * w.y); }
            kt[idx] = (bf16_t)f2bf(v); }
        for (int idx = tid; idx < 256 * 256; idx += NTHR) { const int n = idx >> 8, k = idx & 255, mp = k >> 4, ci = k & 15, dir = n >> 7, p = n & 63, im = (n >> 6) & 1; const f32x2* pp = dir ? pr : pf;
            const f32x2 w = pp[(dir ? mp : (15 - mp)) * 64 + p], bb = pp[1088 + p * 16 + ci];
            we[idx] = (bf16_t)f2bf(im ? (w.x * bb.y + w.y * bb.x) : (w.x * bb.x - w.y * bb.y)); }
        __syncthreads();
    }

    if constexpr (MASK == ALL_PHASES) { layer_body<MASK>(0, karg, ws, xout_raw, lds0, wave, G, bid, NGW, bli); layer_body<MASK>(1, karg, ws, xout_raw, lds0, wave, G, bid, NGW, bli); }
    else { for (int l = l0; l < l1; ++l) layer_body<MASK>(l, karg, ws, xout_raw, lds0, wave, G, bid, NGW, bli); }
    if (PH(17)) { PHASE_IDS(); const float* fg_ = INP(33); float* xo_ = xout;
    for (int r = gw; r < NLAT; r += NGW) {
        float* xr = xo_ + (size_t)r * 1024; f32x4* xp = (f32x4*)xr + lane; f32x4 v[4]; float s = 0.f;
#pragma unroll
        for (int j = 0; j < 4; ++j) { v[j] = xp[64 * j]; s += (v[j].x * v[j].x + v[j].y * v[j].y) + (v[j].z * v[j].z + v[j].w * v[j].w); }
        const float rr = 1.0f / sqrtf(wave_sum(s, lane) * (1.0f / DM) + EPSN);
#pragma unroll
        for (int j = 0; j < 4; ++j) { const f32x4 g = *(const f32x4*)(fg_ + 4 * lane + 256 * j); xp[64 * j] = v[j] * rr * g; }
    } }
}

template <unsigned MASK> static void launch_ph(const Params& p, int l0, int l1, int grid, hipStream_t s) {
    static bool attr = false;
    if (!attr) { if (hipFuncSetAttribute((const void*)hybrid_fwd<MASK>, hipFuncAttributeMaxDynamicSharedMemorySize, LDS_BYTES) != hipSuccess) fprintf(stderr, "kernel_launch: hipFuncSetAttribute failed\n"); attr = true; }
    hipLaunchKernelGGL(hybrid_fwd<MASK>, dim3(grid), dim3(NTHR), LDS_BYTES, s, p, l0, l1, 0);
}
extern "C" void kernel_launch(void* const* d_in, const int* in_sizes, int n_in, void* d_out, int out_size, void* d_ws, size_t ws_size, hipStream_t stream) {
    static int grid = 0;
    if (grid == 0) {
        if (n_in != 34 || out_size != NLAT * DM || ws_size < WS_END) { fprintf(stderr, "kernel_launch: unexpected problem (n_in %d, out %d, ws %zu)\n", n_in, out_size, ws_size); grid = -1; return; }
        int dev = 0, cus = 0;
        if (hipGetDevice(&dev) != hipSuccess || hipDeviceGetAttribute(&cus, hipDeviceAttributeMultiprocessorCount, dev) != hipSuccess) { grid = -1; return; }
        grid = cus;
    }
    if (grid < 0) return;
    (void)hipMemsetAsync((char*)d_ws + WS_CTL, 0, CTL_BYTES, stream);
    Params p{};
    for (int i = 0; i < 34; ++i) p.in[i] = (const float*)d_in[i];
    p.out = (float*)d_out; p.ws = (unsigned char*)d_ws;
#if N_LAUNCHES == 1
    {
        static bool q = false;
        if (!q) { q = true; int per_cu = 0; (void)hipFuncSetAttribute((const void*)hybrid_fwd<ALL_PHASES>, hipFuncAttributeMaxDynamicSharedMemorySize, LDS_BYTES);
            if (hipOccupancyMaxActiveBlocksPerMultiprocessor(&per_cu, (const void*)hybrid_fwd<ALL_PHASES>, NTHR, LDS_BYTES) != hipSuccess || per_cu < 1) fprintf(stderr, "kernel_launch: occupancy query says %d\n", per_cu);
            (void)hipGetLastError(); }
    }
    launch_ph<ALL_PHASES>(p, 0, 2, grid, stream);
#else
    launch_ph<1u << 0>(p, 0, 0, grid, stream);
    launch_ph<1u << 1>(p, 0, 0, grid, stream);
    for (int l = 0; l < 2; ++l) {
        launch_ph<1u << 2>(p, l, l + 1, grid, stream);  launch_ph<1u << 3>(p, l, l + 1, grid, stream);  launch_ph<1u << 4>(p, l, l + 1, grid, stream);
        launch_ph<1u << 5>(p, l, l + 1, grid, stream);  launch_ph<1u << 6>(p, l, l + 1, grid, stream);  launch_ph<1u << 7>(p, l, l + 1, grid, stream);
        launch_ph<1u << 8>(p, l, l + 1, grid, stream);  launch_ph<1u << 9>(p, l, l + 1, grid, stream);  launch_ph<1u << 10>(p, l, l + 1, grid, stream);
        launch_ph<1u << 11>(p, l, l + 1, grid, stream); launch_ph<1u << 12>(p, l, l + 1, grid, stream); launch_ph<1u << 13>(p, l, l + 1, grid, stream);
        launch_ph<1u << 14>(p, l, l + 1, grid, stream); launch_ph<1u << 15>(p, l, l + 1, grid, stream); launch_ph<1u << 16>(p, l, l + 1, grid, stream);
    }
    launch_ph<1u << 17>(p, 0, 0, grid, stream);
#endif
}
```

```cpp
#include <hip/hip_runtime.h>
#include <cstdio>
#include <cstdint>

#define LAS __attribute__((address_space(3)))
typedef unsigned short bf16_t;
typedef short bf16x8 __attribute__((ext_vector_type(8)));
typedef float f32x4 __attribute__((ext_vector_type(4)));
typedef float f32x2 __attribute__((ext_vector_type(2)));
typedef unsigned u32x4 __attribute__((ext_vector_type(4)));
typedef unsigned u32x2 __attribute__((ext_vector_type(2)));

#ifndef N_LAUNCHES
#define N_LAUNCHES 1
#endif
#define PH(k) ((MASK >> (k)) & 1u)
#ifndef DUP_MASK
#define DUP_MASK 0u
#endif
#define REPS(k) for (int rep_ = 0; rep_ < 1 + (int)((((unsigned)DUP_MASK) >> (k)) & 1u); ++rep_)
constexpr unsigned ALL_PHASES = 0x3ffffu;

constexpr int DM = 1024, SEQ = 8192, CTXL = 256, NLAT = 32768, NCTX = 1024, NROW = 33792;
constexpr int NWIN = 6144, KCAT = 1408, S5R = 2304, S5RV = 2112, LCAP = 33792;
constexpr float EPSN = 1e-6f;
constexpr int NWAVES = 8, NTHR = 512;

constexpr size_t MiB = 1u << 20;
constexpr size_t WS_CTL = 0, CTL_BYTES = MiB;
constexpr size_t WS_MOD = 1 * MiB;
constexpr size_t WS_ROPE = 1 * MiB + 256 * 1024;
constexpr size_t WS_S5P = 2 * MiB;
constexpr size_t WS_WPL = 6 * MiB, WPL_STRIDE = 27 * MiB;
constexpr size_t WO_WIN = 0, WO_WCAT = 12 * MiB, WO_WOUT = 15 * MiB, WO_WR = 17 * MiB, WO_GLU = 17 * MiB + 512 * 1024, WO_KT = 18 * MiB, WO_WEND = 24 * MiB;
constexpr size_t WS_XC = 60 * MiB;
constexpr size_t WS_Y = 64 * MiB;
constexpr size_t WS_E = 155 * MiB;
constexpr size_t WS_UVG = 182 * MiB;
constexpr size_t WS_QK = 248 * MiB;
constexpr size_t WS_VT = 314 * MiB;
constexpr size_t WS_G = 347 * MiB;
constexpr size_t WS_S5A = 446 * MiB;
constexpr size_t WS_END = 500 * MiB;
constexpr size_t WS_LOGITS = WS_QK, WS_LTOK = WS_QK + 20 * MiB, WS_LW = WS_QK + 30 * MiB;
constexpr size_t WS_HID = WS_G, WS_WGU = WS_G + 42 * MiB, WS_WD = WS_G + 74 * MiB;
constexpr int CW_BAR = 4096, CW_CNT = 8192;

constexpr int LDS_STAGE = 131072, LDS_BYTES = 155648, LDS_MISC = LDS_BYTES - 1024;

__device__ __forceinline__ unsigned f2bf(float f) { unsigned u = __builtin_bit_cast(unsigned, f); return (u + 0x7fffu + ((u >> 16) & 1u)) >> 16; }
__device__ __forceinline__ float bf2f(unsigned b) { return __builtin_bit_cast(float, b << 16); }
__device__ __forceinline__ unsigned cvt_pk_bf16(float lo, float hi) { unsigned r; asm volatile("v_cvt_pk_bf16_f32 %0, %1, %2" : "=v"(r) : "v"(lo), "v"(hi)); return r; }
template <int M> __device__ __forceinline__ float shx(float v, int lane) {
    if constexpr (M < 32) return __builtin_bit_cast(float, __builtin_amdgcn_ds_swizzle(__builtin_bit_cast(int, v), (M << 10) | 0x1f));
    else return __builtin_bit_cast(float, __builtin_amdgcn_ds_bpermute((lane ^ 32) << 2, __builtin_bit_cast(int, v)));
}
__device__ __forceinline__ float wave_sum(float v, int lane) {
    v += shx<1>(v, lane); v += shx<2>(v, lane); v += shx<4>(v, lane); v += shx<8>(v, lane); v += shx<16>(v, lane); v += shx<32>(v, lane);
    return v;
}
__device__ __forceinline__ float gelu_tanh(float x) { const float z2 = 1.5957691216f * (x + 0.044715f * x * x * x); return x * __builtin_amdgcn_rcpf(1.0f + __expf(-z2)); }
__device__ __forceinline__ float sigmoidf_(float x) { return __builtin_amdgcn_rcpf(1.0f + __expf(-x)); }
#define LDS_WAIT() asm volatile("s_waitcnt lgkmcnt(0)" ::: "memory")
template <class T> __device__ __forceinline__ T* opq(T* p) { asm volatile("" : "+s"(p)); return p; }
__device__ __forceinline__ int opq_v(int v) { asm volatile("" : "+v"(v)); return v; }
__device__ __forceinline__ unsigned opq_u(unsigned v) { asm volatile("" : "+v"(v)); return v; }
__device__ __forceinline__ LAS unsigned char* opq_l(LAS unsigned char* p) { unsigned v = (unsigned)(size_t)p; asm volatile("" : "+s"(v)); return (LAS unsigned char*)(size_t)v; }

#define XB_TMO      128
#define XB_XCNT(j)  (256  + 64 * (j))
#define XB_XSUB(j)  (1280 + 64 * (j))
#define XB_XGEN(j)  (2304 + 64 * (j))
#define XB_TOP      3328
#define XB_TOPGEN   3392
#define XCD_BAR_WORDS 3456
#define XB_SPIN_CAP (1u << 18)
__device__ __forceinline__ unsigned xb_ld(unsigned* p)              { return __hip_atomic_load(p, __ATOMIC_RELAXED, __HIP_MEMORY_SCOPE_AGENT); }
__device__ __forceinline__ unsigned xb_add(unsigned* p, unsigned v) { return __hip_atomic_fetch_add(p, v, __ATOMIC_RELAXED, __HIP_MEMORY_SCOPE_AGENT); }
__device__ __forceinline__ unsigned xb_xcc_id() { return (unsigned)__builtin_amdgcn_s_getreg((3 << 11) | 20) & 0xFu; }
#define XB_SPIN(cond, bar) do { unsigned _sp = 0; while (cond) { __builtin_amdgcn_s_sleep(1); \
    if ((++_sp & 255u) == 0u) { if (xb_ld(&(bar)[XB_TMO])) break; if (_sp > XB_SPIN_CAP) { atomicAdd(&(bar)[XB_TMO], 1u); break; } } } } while (0)
struct XcdBarrier { unsigned* bar; unsigned x; volatile LAS unsigned* st; };
__device__ __forceinline__ XcdBarrier xcd_barrier_post(unsigned* bar, volatile LAS unsigned* st) {
    XcdBarrier b; b.bar = bar; b.x = xb_xcc_id(); b.st = st;
    if (threadIdx.x == 0) (void)xb_add(&bar[XB_XCNT(b.x)], 1u);
    return b;
}
__device__ __forceinline__ void xcd_barrier_complete(unsigned* bar, unsigned x, unsigned& nloc, unsigned& nx) {
    const unsigned G = gridDim.x * gridDim.y * gridDim.z;
    unsigned sum, cnt, mine, sp = 0u;
    for (;;) {
        sum = 0u; cnt = 0u; mine = 0u;
#pragma unroll
        for (unsigned j = 0; j < 16; ++j) { const unsigned c = xb_ld(&bar[XB_XCNT(j)]); sum += c; cnt += (c > 0u) ? 1u : 0u; mine = (j == x) ? c : mine; }
        if (sum == G) break;
        __builtin_amdgcn_s_sleep(1);
        if ((++sp & 255u) == 0u) { if (xb_ld(&bar[XB_TMO])) break; if (sp > XB_SPIN_CAP) { atomicAdd(&bar[XB_TMO], 1u); break; } }
    }
    nloc = mine > 0u ? mine : 1u; nx = cnt > 0u ? cnt : 1u;
}
__device__ __forceinline__ void xcd_barrier(const XcdBarrier& b) {
    asm volatile("s_waitcnt vmcnt(0)" ::: "memory");
    __syncthreads();
    if (threadIdx.x == 0) {
        unsigned* bar = b.bar;
        __builtin_amdgcn_s_waitcnt(0);
        unsigned nloc = b.st[0], nx = b.st[1];
        if (nloc == 0u) { xcd_barrier_complete(bar, b.x, nloc, nx); b.st[0] = nloc; b.st[1] = nx; }
        const unsigned old = xb_add(&bar[XB_XSUB(b.x)], 1u);
        const unsigned gen = old / nloc;
        if (old + 1u == (gen + 1u) * nloc) {
            __builtin_amdgcn_fence(__ATOMIC_RELEASE, "agent");
            asm volatile("s_waitcnt vmcnt(0)" ::: "memory");
            const unsigned og = xb_add(&bar[XB_TOP], 1u);
            const unsigned tg = og / nx;
            if (og + 1u == (tg + 1u) * nx) xb_add(&bar[XB_TOPGEN], 1u);
            else XB_SPIN(xb_ld(&bar[XB_TOPGEN]) == tg, bar);
            __builtin_amdgcn_fence(__ATOMIC_ACQUIRE, "agent");
            xb_add(&bar[XB_XGEN(b.x)], 1u);
            asm volatile("s_waitcnt vmcnt(0)" ::: "memory");
        } else {
            XB_SPIN(xb_ld(&bar[XB_XGEN(b.x)]) == gen, bar);
            __builtin_amdgcn_fence(__ATOMIC_ACQUIRE, "agent");
            asm volatile("s_waitcnt vmcnt(0)" ::: "memory");
        }
    }
    __syncthreads();
}

namespace g8 {
constexpr int BM = 256, BK = 64, HALF = 128, HTB = HALF * BK * 2, NXCD = 8, WGM = 8;
__device__ __forceinline__ int lds_byte(int r, int c) { const int st = (r >> 4) * 2 + (c >> 5), rr = r & 15, cc = c & 31, ob = rr * 64 + cc * 2; return st * 1024 + (ob ^ (((ob >> 9) & 1) << 5)); }
__device__ __forceinline__ void stage_rc(int b, int& R, int& C) { const int st = b / 1024, sb = b % 1024, swz = sb ^ (((sb >> 9) & 1) << 5); R = (st >> 1) * 16 + swz / 64; C = (st & 1) * 32 + (swz % 64) / 2; }
__device__ __forceinline__ int perm32(int rho) { const int n = rho >> 4, i = rho & 15; return 8 * (i >> 2) + 4 * n + (i & 3); }

struct GUnit { int pm, pn; unsigned a, b; int x, y; };

struct SchedDense {
    static constexpr bool GATHER = false;
    const char* A; const char* B; unsigned tsA, tsB; int nM, nN, nwg, G, c;
    __device__ __forceinline__ void init(const void* A_, const void* B_, int M, int N, int lda, int ldb, int G_, int c_) {
        A = (const char*)A_; B = (const char*)B_; nM = M / BM; nN = N / BM; nwg = nM * nN; G = G_; c = c_; tsA = (unsigned)(BM * lda * 2); tsB = (unsigned)(BM * ldb * 2); }
    __device__ __forceinline__ bool next(int i, GUnit& u) const {
        const long L = (long)i * G + c; if (L >= nwg) return false;
        int wgid = (int)L; { const int q = nwg / NXCD, r = nwg % NXCD, xcd = wgid % NXCD, off = wgid / NXCD; wgid = (xcd < r ? xcd * (q + 1) : r * (q + 1) + (xcd - r) * q) + off; }
        const int nig = WGM * nN, gid = wgid / nig, fm = gid * WGM, gsz = (nM - fm) < WGM ? (nM - fm) : WGM;
        u.pm = fm + ((wgid % nig) % gsz); u.pn = (wgid % nig) / gsz; u.a = (unsigned)u.pm * tsA; u.b = (unsigned)u.pn * tsB; u.x = 0; u.y = 0; return true;
    }
    __device__ __forceinline__ unsigned arow(const GUnit&, int) const { return 0u; }
};
struct SchedS5 {
    static constexpr bool GATHER = false;
    const char* A; const char* B; unsigned bstride; int G, c;
    __device__ __forceinline__ bool next(int i, GUnit& u) const {
        const int L = i * G + c; if (L >= 24 * 9) return false;
        const int g = L / 9, tl = L % 9; u.pm = tl; u.pn = 0; u.x = g; u.y = 0;
        u.a = (unsigned)((g * S5R + 256 * tl) * 512) * 2u; u.b = (unsigned)g * bstride; return true;
    }
    __device__ __forceinline__ unsigned arow(const GUnit&, int) const { return 0u; }
};
struct SchedMoeUp {
    static constexpr bool GATHER = true;
    const char* A; const char* B; const int* ltok; const LAS int* tstart; const LAS int* cnt; int G, c;
    __device__ __forceinline__ bool next(int i, GUnit& u) const {
        const int L = i * G + c; const int T = L >> 1; if (T >= tstart[64]) return false;
        int q = 0;
#pragma unroll 1
        for (int j = 1; j < 64; ++j) q += (tstart[j] <= T) ? 1 : 0;
        u.pm = T; u.pn = L & 1; u.x = q; u.y = T - tstart[q]; u.a = 0u; u.b = (unsigned)(((q & 31) * 512 + (L & 1) * 256) * 1024) * 2u; return true;
    }
    __device__ __forceinline__ unsigned arow(const GUnit& u, int R) const {
        const int idx = 256 * u.y + R; const int tok = idx < cnt[u.x] ? ltok[(size_t)u.x * LCAP + idx] : 0; return (unsigned)tok * 2048u; }
};
struct SchedMoeDown {
    static constexpr bool GATHER = false;
    const char* A; const char* B; const LAS int* tstart; int rank, G, c;
    __device__ __forceinline__ bool next(int i, GUnit& u) const {
        const int L = i * G + c; const int T = tstart[32 * rank] + (L >> 2); if (T >= tstart[32 * rank + 32]) return false;
        int q = 0;
#pragma unroll 1
        for (int j = 1; j < 64; ++j) q += (tstart[j] <= T) ? 1 : 0;
        u.pm = T; u.pn = L & 3; u.x = q; u.y = T - tstart[q]; u.a = (unsigned)(T * 256 * 256) * 2u; u.b = (unsigned)(((q & 31) * 1024 + (L & 3) * 256) * 256) * 2u; return true;
    }
    __device__ __forceinline__ unsigned arow(const GUnit&, int) const { return 0u; }
};

template <class Epi, class Sched>
__device__ __forceinline__ void gemm_run(LAS unsigned char* lds, const int K, const int lda, const int ldb, const Sched& S, const Epi& E) {
    const int tid = opq_v((int)threadIdx.x), wid = __builtin_amdgcn_readfirstlane(tid >> 6), lane = tid & 63, wr = wid >> 2, wc = wid & 3, fr = lane & 15, fq = lane >> 4;
    const int nt = K / BK;
    constexpr int NH = Sched::GATHER ? 2 : 1;
    unsigned voffB[2], vAc[NH][2];
#pragma unroll
    for (int i = 0; i < 2; ++i) { int R, C; stage_rc(tid * 16 + i * 8192, R, C); const int Rb = Epi::PERM ? ((R & ~31) + perm32(R & 31)) : R;
        voffB[i] = (unsigned)(Rb * ldb + C) * 2u; }
    constexpr unsigned kstep = BK * 2;
    const unsigned hstepB = (unsigned)(HALF * ldb * 2);
    const unsigned hstepA = Sched::GATHER ? 0u : (unsigned)(HALF * lda * 2);
    const char* const baseA = S.A; const char* const baseB = S.B;
    const unsigned ldsw = (unsigned)wid * 1024u;
    const int aoff = lds_byte(wr * 64 + fr, fq * 8), boff = lds_byte(wc * 32 + fr, fq * 8);
#define G8_SA(b, h) (((b) * 2 + (h)) * HTB)
#define G8_SB(b, h) ((4 + (b) * 2 + (h)) * HTB)
#define G8_STAGE_A(bufoff, gbase, VA, h) do { _Pragma("unroll") for (int _i = 0; _i < 2; ++_i) \
        __builtin_amdgcn_global_load_lds((const unsigned*)(baseA + ((gbase) + (h) * hstepA) + opq_u((VA)[(h) * (NH - 1)][_i])), (LAS unsigned*)(lds + (bufoff) + ldsw + _i * 8192), 16, 0, 0); } while (0)
#define G8_STAGE_B(bufoff, gbase) do { _Pragma("unroll") for (int _i = 0; _i < 2; ++_i) \
        __builtin_amdgcn_global_load_lds((const unsigned*)(baseB + (gbase) + opq_u(voffB[_i])), (LAS unsigned*)(lds + (bufoff) + ldsw + _i * 8192), 16, 0, 0); } while (0)
#define G8_LDA(dst, b, h) do { _Pragma("unroll") for (int m = 0; m < 4; ++m) _Pragma("unroll") for (int k = 0; k < 2; ++k) dst[m][k] = *(const LAS bf16x8*)(lds + G8_SA(b, h) + aoff + m * 2048 + k * 1024); } while (0)
#define G8_LDB(dst, b, h) do { _Pragma("unroll") for (int n = 0; n < 2; ++n) _Pragma("unroll") for (int k = 0; k < 2; ++k) dst[n][k] = *(const LAS bf16x8*)(lds + G8_SB(b, h) + boff + n * 2048 + k * 1024); } while (0)
#define G8_MMA(ai, bj, At, Bt) do { __builtin_amdgcn_s_setprio(1); _Pragma("unroll") for (int m = 0; m < 4; ++m) _Pragma("unroll") for (int n = 0; n < 2; ++n) _Pragma("unroll") for (int k = 0; k < 2; ++k) \
        acc[ai][bj][m][n] = __builtin_amdgcn_mfma_f32_16x16x32_bf16(Bt[n][k], At[m][k], acc[ai][bj][m][n], 0, 0, 0); __builtin_amdgcn_s_setprio(0); } while (0)
#define G8_WAIT_V(n) asm volatile("s_waitcnt vmcnt(" #n ")" ::: "memory")
#define G8_WAIT_L(n) asm volatile("s_waitcnt lgkmcnt(" #n ")" ::: "memory")
#define G8_BAR __builtin_amdgcn_s_barrier()
#define G8_SCHED __builtin_amdgcn_sched_barrier(0)
#define G8_KPAIR_A(a1) do { \
            G8_LDB(B0, 0, 0); G8_LDB(B1, 0, 1); G8_SCHED; G8_LDA(At, 0, 0); G8_STAGE_A(G8_SA(1, 1), (a1), vAc, 1); \
            G8_WAIT_V(8); G8_WAIT_L(0); G8_BAR; G8_MMA(0, 0, At, B0); G8_MMA(0, 1, At, B1); G8_BAR; G8_SCHED; } while (0)
#define G8_KPAIR_B(a2, b2, VA2) do { \
            G8_LDA(At, 0, 1); G8_STAGE_B(G8_SB(0, 0), (b2)); G8_STAGE_B(G8_SB(0, 1), (b2) + hstepB); G8_STAGE_A(G8_SA(0, 0), (a2), VA2, 0); \
            G8_WAIT_V(8); G8_WAIT_L(0); G8_BAR; G8_MMA(1, 0, At, B0); G8_MMA(1, 1, At, B1); G8_BAR; G8_SCHED; \
            G8_LDB(B0, 1, 0); G8_LDB(B1, 1, 1); G8_SCHED; G8_LDA(At, 1, 0); G8_STAGE_A(G8_SA(0, 1), (a2), VA2, 1); \
            G8_WAIT_V(8); G8_WAIT_L(0); G8_BAR; G8_MMA(0, 0, At, B0); G8_MMA(0, 1, At, B1); G8_BAR; G8_SCHED; \
            G8_LDA(At, 1, 1); G8_STAGE_B(G8_SB(1, 0), (b2) + kstep); G8_STAGE_B(G8_SB(1, 1), (b2) + kstep + hstepB); G8_STAGE_A(G8_SA(1, 0), (a2) + kstep, VA2, 0); \
            G8_WAIT_V(8); G8_WAIT_L(0); G8_BAR; G8_MMA(1, 0, At, B0); G8_MMA(1, 1, At, B1); G8_BAR; G8_SCHED; } while (0)
#define G8_KPAIR(a1, a2, b2, VA2) do { G8_KPAIR_A(a1); G8_KPAIR_B(a2, b2, VA2); } while (0)
    GUnit cur, nxt; int ui = 0;
    if (!S.next(0, cur)) return;
    f32x4 acc[2][2][4][2];
#pragma unroll
    for (int a = 0; a < 2; ++a)
#pragma unroll
        for (int b = 0; b < 2; ++b)
#pragma unroll
            for (int m = 0; m < 4; ++m)
#pragma unroll
                for (int n = 0; n < 2; ++n) acc[a][b][m][n] = (f32x4){0.f, 0.f, 0.f, 0.f};
    bf16x8 At[4][2], B0[2][2], B1[2][2];
#pragma unroll
    for (int h = 0; h < NH; ++h)
#pragma unroll
        for (int i = 0; i < 2; ++i) { int R, C; stage_rc(tid * 16 + i * 8192, R, C);
            if constexpr (Sched::GATHER) vAc[h][i] = S.arow(cur, R + HALF * h) + (unsigned)C * 2u;
            else vAc[h][i] = (unsigned)(R * lda + C) * 2u; }
    unsigned cA = cur.a, cB = cur.b;
    G8_STAGE_B(G8_SB(0, 0), cB); G8_STAGE_B(G8_SB(0, 1), cB + hstepB); G8_STAGE_A(G8_SA(0, 0), cA, vAc, 0); G8_STAGE_A(G8_SA(0, 1), cA, vAc, 1);
    if (wr == 1) G8_BAR;
    G8_WAIT_V(2); G8_BAR;
    G8_STAGE_B(G8_SB(1, 0), cB + kstep); G8_STAGE_A(G8_SA(1, 0), cA + kstep, vAc, 0); G8_STAGE_B(G8_SB(1, 1), cB + kstep + hstepB);
    G8_WAIT_V(6); G8_BAR;
    for (;;) {
        const bool has_next = S.next(ui + 1, nxt);
        const unsigned nA = has_next ? nxt.a : cA, nB = has_next ? nxt.b : cB;
        for (int t = 0; t < nt - 2; t += 2) { const unsigned a1 = cA + (unsigned)(t + 1) * kstep, a2 = cA + (unsigned)(t + 2) * kstep, b2 = cB + (unsigned)(t + 2) * kstep; G8_KPAIR(a1, a2, b2, vAc); }
        {
            const unsigned a1 = cA + (unsigned)(nt - 1) * kstep;
            if constexpr (Sched::GATHER) {
                G8_KPAIR_A(a1);
                if (has_next) {
#pragma unroll
                    for (int h = 0; h < 2; ++h)
#pragma unroll
                        for (int i = 0; i < 2; ++i) { int R, C; stage_rc(tid * 16 + i * 8192, R, C); vAc[h][i] = S.arow(nxt, R + HALF * h) + (unsigned)C * 2u; }
                }
                G8_KPAIR_B(nA, nB, vAc);
            } else {
                G8_KPAIR(a1, nA, nB, vAc);
            }
        }
        if (wr == 0) G8_BAR;
        E(acc, cur, wr, wc, opq_v(fr), opq_v(fq));
        if (!has_next) break;
#pragma unroll
        for (int a = 0; a < 2; ++a)
#pragma unroll
            for (int b = 0; b < 2; ++b)
#pragma unroll
                for (int m = 0; m < 4; ++m)
#pragma unroll
                    for (int n = 0; n < 2; ++n) acc[a][b][m][n] = (f32x4){0.f, 0.f, 0.f, 0.f};
        cur = nxt; cA = nA; cB = nB; ++ui;
        if (wr == 1) G8_BAR;
    }
    G8_WAIT_V(0);
    G8_BAR;
#undef G8_SA
#undef G8_SB
#undef G8_STAGE_A
#undef G8_STAGE_B
#undef G8_LDA
#undef G8_LDB
#undef G8_MMA
#undef G8_WAIT_V
#undef G8_WAIT_L
#undef G8_BAR
#undef G8_SCHED
#undef G8_KPAIR
#undef G8_KPAIR_A
#undef G8_KPAIR_B
}

typedef f32x4 Acc[2][2][4][2];

__device__ __forceinline__ u32x4 pack8(const f32x4 v0, const f32x4 v1) { u32x4 w; w.x = cvt_pk_bf16(v0[0], v0[1]); w.y = cvt_pk_bf16(v0[2], v0[3]); w.z = cvt_pk_bf16(v1[0], v1[1]); w.w = cvt_pk_bf16(v1[2], v1[3]); return w; }

struct EpiWin {
    static constexpr bool PERM = true;
    unsigned char* wsb;
    __device__ __forceinline__ void operator()(Acc& acc, const GUnit& u, int wr, int wc, int fr, int fq) const {
        bf16_t* const uvg = (bf16_t*)(wsb + WS_UVG); bf16_t* const qk = (bf16_t*)(wsb + WS_QK); bf16_t* const vt = (bf16_t*)(wsb + WS_VT); bf16_t* const vtc = (bf16_t*)(wsb + WS_VT + 32 * MiB);
        unsigned char* const gates = wsb + WS_G; bf16_t* const s5a = (bf16_t*)(wsb + WS_S5A); const float* const ropec = (const float*)(wsb + WS_ROPE); const float* const ropes = ropec + 128 * 16;
        const int pn = u.pn, row0 = u.pm * 256 + wr * 64 + fr, cl = wc * 32 + 8 * fq;
        if (pn < 4) {
#pragma unroll
            for (int ai = 0; ai < 2; ++ai)
#pragma unroll
                for (int m = 0; m < 4; ++m) { bf16_t* rp = uvg + (size_t)(row0 + ai * 128 + m * 16) * 1024 + pn * 256 + cl;
#pragma unroll
                    for (int bj = 0; bj < 2; ++bj) { f32x4 v0 = acc[ai][bj][m][0], v1 = acc[ai][bj][m][1];
#pragma unroll
                        for (int j = 0; j < 4; ++j) { v0[j] = gelu_tanh(v0[j]); v1[j] = gelu_tanh(v1[j]); }
                        *(u32x4*)(rp + bj * 128) = pack8(v0, v1); } }
        } else if (pn < 8) {
            const float sc = pn < 6 ? 0.125f : 1.0f; const bool lat = u.pm < 128; const int seg = wc & 1, f0 = 8 * (fq & 1); const float sg = fq < 2 ? -1.f : 1.f;
#pragma unroll
            for (int ai = 0; ai < 2; ++ai) { const int grow = (4 * u.pm + 2 * ai + wr) & 127;
#pragma unroll
                for (int m = 0; m < 4; ++m) { bf16_t* rp = qk + (size_t)(row0 + ai * 128 + m * 16) * 1024 + (pn - 4) * 256 + cl;
                    const int pos = seg ? (16 * m + fr) : grow;
                    f32x4 c0 = {1.f, 1.f, 1.f, 1.f}, c1 = c0, s0 = {0.f, 0.f, 0.f, 0.f}, s1 = s0;
                    if (lat) { c0 = *(const f32x4*)(ropec + pos * 16 + f0); c1 = *(const f32x4*)(ropec + pos * 16 + f0 + 4); s0 = *(const f32x4*)(ropes + pos * 16 + f0); s1 = *(const f32x4*)(ropes + pos * 16 + f0 + 4); }
#pragma unroll
                    for (int bj = 0; bj < 2; ++bj) { f32x4 v0 = acc[ai][bj][m][0], v1 = acc[ai][bj][m][1], o0, o1;
#pragma unroll
                        for (int j = 0; j < 4; ++j) { const float x0 = shx<32>(v0[j], fr + 16 * fq), x1 = shx<32>(v1[j], fr + 16 * fq);
                            o0[j] = (v0[j] * c0[j] + sg * x0 * s0[j]) * sc; o1[j] = (v1[j] * c1[j] + sg * x1 * s1[j]) * sc; }
                        *(u32x4*)(rp + bj * 128) = pack8(o0, o1); } } }
        } else if (pn < 10) {
#pragma unroll
            for (int ai = 0; ai < 2; ++ai)
#pragma unroll
                for (int m = 0; m < 4; ++m) { const int row = row0 + ai * 128 + m * 16; bf16_t* bp; size_t stride;
                    if (row < NLAT) { bp = vt + (size_t)((row >> 13) * 512) * 8192 + (row & 8191); stride = 8192; }
                    else { const int rr = row - NLAT; bp = vtc + (size_t)((rr >> 8) * 512) * 256 + (rr & 255); stride = 256; }
#pragma unroll
                    for (int bj = 0; bj < 2; ++bj) { const int c = (pn - 8) * 256 + bj * 128 + cl;
#pragma unroll
                        for (int n = 0; n < 2; ++n)
#pragma unroll
                            for (int j = 0; j < 4; ++j) bp[(size_t)(c + 4 * n + j) * stride] = (bf16_t)f2bf(acc[ai][bj][m][n][j]); } }
        } else if (pn < 22) {
#pragma unroll
            for (int ai = 0; ai < 2; ++ai)
#pragma unroll
                for (int m = 0; m < 4; ++m) { unsigned char* rp = gates + (size_t)(row0 + ai * 128 + m * 16) * 3072 + (pn - 10) * 256 + cl;
#pragma unroll
                    for (int bj = 0; bj < 2; ++bj) { u32x2 w;
#pragma unroll
                        for (int n = 0; n < 2; ++n) { unsigned pk = 0;
#pragma unroll
                            for (int j = 0; j < 4; ++j) { float q = __builtin_rintf(sigmoidf_(acc[ai][bj][m][n][j]) * 255.0f); q = fminf(fmaxf(q, 1.0f), 255.0f); pk |= ((unsigned)q) << (8 * j); }
                            w[n] = pk; }
                        *(u32x2*)(rp + bj * 128) = w; } }
        } else {
#pragma unroll
            for (int bj = 0; bj < 2; ++bj) { const int ch = (pn - 22) * 256 + bj * 128 + cl;
                if (ch < 384) { const int g = ch >> 4, c0 = ch & 15;
#pragma unroll
                    for (int ai = 0; ai < 2; ++ai)
#pragma unroll
                        for (int m = 0; m < 4; ++m) { const int row = row0 + ai * 128 + m * 16;
                            *(u32x4*)(s5a + ((size_t)(g * S5R + (row >> 4)) * 512) + (row & 15) * 16 + c0) = pack8(acc[ai][bj][m][0], acc[ai][bj][m][1]); } } }
        }
    }
};

struct EpiMerge {
    static constexpr bool PERM = true;
    const unsigned char* gates; bf16_t* mb; int j;
    __device__ __forceinline__ void operator()(Acc& acc, const GUnit& u, int wr, int wc, int fr, int fq) const {
        const int row0 = u.pm * 256 + wr * 64 + fr, col = u.pn * 256 + wc * 32 + 8 * fq;
#pragma unroll
        for (int ai = 0; ai < 2; ++ai)
#pragma unroll
            for (int m = 0; m < 4; ++m) { const size_t row = (size_t)(row0 + ai * 128 + m * 16); const unsigned char* rp = gates + row * 3072 + 1024 * j + col;
#pragma unroll
                for (int bj = 0; bj < 2; ++bj) { const u32x2 gc = *(const u32x2*)(rp + bj * 128); bf16_t* mp = mb + row * 1024 + col + bj * 128; f32x4 v0, v1;
                    u32x4 pv = {0u, 0u, 0u, 0u}; if (j > 0) pv = *(const u32x4*)mp;
#pragma unroll
                    for (int k = 0; k < 4; ++k) { v0[k] = acc[ai][bj][m][0][k] * ((float)((gc[0] >> (8 * k)) & 255u) * (1.0f / 255.0f)); v1[k] = acc[ai][bj][m][1][k] * ((float)((gc[1] >> (8 * k)) & 255u) * (1.0f / 255.0f)); }
#pragma unroll
                    for (int k = 0; k < 2; ++k) { v0[2 * k] += bf2f(pv[k] & 0xffffu); v0[2 * k + 1] += bf2f(pv[k] >> 16); v1[2 * k] += bf2f(pv[2 + k] & 0xffffu); v1[2 * k + 1] += bf2f(pv[2 + k] >> 16); }
                    *(u32x4*)mp = pack8(v0, v1); }
                asm volatile("" ::: "memory"); }
    }
};

struct EpiWout {
    static constexpr bool PERM = false;
    const float* old_lat; const float* old_ctx; float* new_lat; float* new_ctx; const float* modl; float sc;
    __device__ __forceinline__ void operator()(Acc& acc, const GUnit& u, int wr, int wc, int fr, int fq) const {
        const bool lat = u.pm < 128; const int mrow = lat ? (u.pm >> 5) : 4;
        const float* gp = modl + mrow * 6144 + 2048; const int col0 = u.pn * 256 + wc * 32 + 4 * fq;
        const int rbase = (lat ? u.pm * 256 : (u.pm - 128) * 256) + wr * 64 + fr;
        const float* op = lat ? old_lat : old_ctx; float* np = lat ? new_lat : new_ctx;
        f32x4 gv[2][2];
#pragma unroll
        for (int bj = 0; bj < 2; ++bj)
#pragma unroll
            for (int n = 0; n < 2; ++n) gv[bj][n] = *(const f32x4*)(gp + col0 + bj * 128 + n * 16) * sc;
#pragma unroll
        for (int ai = 0; ai < 2; ++ai)
#pragma unroll
            for (int m = 0; m < 4; ++m) { const size_t off = (size_t)(rbase + ai * 128 + m * 16) * 1024 + col0;
#pragma unroll
                for (int bj = 0; bj < 2; ++bj)
#pragma unroll
                    for (int n = 0; n < 2; ++n) { const f32x4 xo = *(const f32x4*)(op + off + bj * 128 + n * 16); *(f32x4*)(np + off + bj * 128 + n * 16) = xo + gv[bj][n] * acc[ai][bj][m][n]; }
                asm volatile("" ::: "memory"); }
    }
};

struct EpiLogits {
    static constexpr bool PERM = false;
    float* lg;
    __device__ __forceinline__ void operator()(Acc& acc, const GUnit& u, int wr, int wc, int fr, int fq) const {
        const int row0 = u.pm * 256 + wr * 64 + fr, col0 = wc * 32 + 4 * fq;
#pragma unroll
        for (int ai = 0; ai < 2; ++ai)
#pragma unroll
            for (int m = 0; m < 4; ++m) { float* rp = lg + (size_t)(row0 + ai * 128 + m * 16) * 128 + col0;
#pragma unroll
                for (int n = 0; n < 2; ++n) *(f32x4*)(rp + n * 16) = acc[ai][0][m][n]; }
    }
};

struct EpiS5E {
    static constexpr bool PERM = true;
    bf16_t* e;
    __device__ __forceinline__ void operator()(Acc& acc, const GUnit& u, int wr, int wc, int fr, int fq) const {
        const int R0 = u.pm * 256 + wr * 64 + fr, cl = wc * 32 + 8 * fq;
#pragma unroll
        for (int ai = 0; ai < 2; ++ai)
#pragma unroll
            for (int m = 0; m < 4; ++m) { bf16_t* rp = e + ((size_t)(u.x * S5R + R0 + ai * 128 + m * 16) * 256) + cl;
#pragma unroll
                for (int bj = 0; bj < 2; ++bj) *(u32x4*)(rp + bj * 128) = pack8(acc[ai][bj][m][0], acc[ai][bj][m][1]); }
    }
};

struct EpiS5Y {
    static constexpr bool PERM = true;
    bf16_t* yg;
    __device__ __forceinline__ void operator()(Acc& acc, const GUnit& u, int wr, int wc, int fr, int fq) const {
        const int R0 = u.pm * 256 + wr * 64 + fr, cl = wc * 32 + 8 * fq;
#pragma unroll
        for (int ai = 0; ai < 2; ++ai)
#pragma unroll
            for (int m = 0; m < 4; ++m) { const int R = R0 + ai * 128 + m * 16;
                if (R < S5RV) {
#pragma unroll
                    for (int bj = 0; bj < 2; ++bj) { const int col8 = bj * 128 + cl, i = col8 >> 4, co0 = col8 & 15; f32x4 v0 = acc[ai][bj][m][0], v1 = acc[ai][bj][m][1];
#pragma unroll
                        for (int j = 0; j < 4; ++j) { v0[j] = gelu_tanh(v0[j]); v1[j] = gelu_tanh(v1[j]); }
                        *(u32x4*)(yg + (size_t)(16 * R + i) * 384 + 16 * u.x + co0) = pack8(v0, v1); } } }
    }
};

struct EpiGlu {
    static constexpr bool PERM = true;
    const bf16_t* yg; bf16_t* ycat;
    __device__ __forceinline__ void operator()(Acc& acc, const GUnit& u, int wr, int wc, int fr, int fq) const {
        const int row0 = u.pm * 256 + wr * 64 + fr, col0 = u.pn * 256 + wc * 32 + 8 * fq;
#pragma unroll
        for (int ai = 0; ai < 2; ++ai)
#pragma unroll
            for (int m = 0; m < 4; ++m) { const size_t row = (size_t)(row0 + ai * 128 + m * 16);
#pragma unroll
                for (int bj = 0; bj < 2; ++bj) {
                    if (u.pn == 0 || bj == 0) { const int col = col0 + bj * 128;
                        const u32x4 y = *(const u32x4*)(yg + row * 384 + col); f32x4 v0, v1;
#pragma unroll
                        for (int j = 0; j < 2; ++j) { v0[2 * j] = bf2f(y[j] & 0xffffu) * sigmoidf_(acc[ai][bj][m][0][2 * j]); v0[2 * j + 1] = bf2f(y[j] >> 16) * sigmoidf_(acc[ai][bj][m][0][2 * j + 1]);
                            v1[2 * j] = bf2f(y[2 + j] & 0xffffu) * sigmoidf_(acc[ai][bj][m][1][2 * j]); v1[2 * j + 1] = bf2f(y[2 + j] >> 16) * sigmoidf_(acc[ai][bj][m][1][2 * j + 1]); }
                        *(u32x4*)(ycat + row * KCAT + 512 + col) = pack8(v0, v1); } }
                asm volatile("" ::: "memory"); }
    }
};

struct EpiMoeUp {
    static constexpr bool PERM = true;
    bf16_t* hid; const float* lw; const LAS int* cnt;
    __device__ __forceinline__ void operator()(Acc& acc, const GUnit& u, int wr, int wc, int fr, int fq) const {
        const int rit0 = wr * 64 + fr, cl = wc * 32 + 8 * fq; const int n_l = cnt[u.x];
#pragma unroll
        for (int ai = 0; ai < 2; ++ai)
#pragma unroll
            for (int m = 0; m < 4; ++m) { const int rit = rit0 + ai * 128 + m * 16, idx = 256 * u.y + rit;
                const float cw = idx < n_l ? lw[(size_t)u.x * LCAP + idx] : 0.f; f32x4 v0, v1;
#pragma unroll
                for (int j = 0; j < 4; ++j) { const float g0 = acc[ai][0][m][0][j], g1 = acc[ai][0][m][1][j];
                    v0[j] = g0 * sigmoidf_(g0) * acc[ai][1][m][0][j] * cw; v1[j] = g1 * sigmoidf_(g1) * acc[ai][1][m][1][j] * cw; }
                *(u32x4*)(hid + ((size_t)(256 * u.pm + rit) * 256) + 128 * u.pn + cl) = pack8(v0, v1); }
    }
};

struct EpiMoeDown {
    static constexpr bool PERM = false;
    float* xlat; float* xc; const float* modl; const int* ltok; const LAS int* cnt; float sc;
    __device__ __forceinline__ void operator()(Acc& acc, const GUnit& u, int wr, int wc, int fr, int fq) const {
        const int rit0 = wr * 64 + fr, col0 = u.pn * 256 + wc * 32 + 4 * fq; const int n_l = cnt[u.x];
        int tk[2][4];
#pragma unroll
        for (int ai = 0; ai < 2; ++ai)
#pragma unroll
            for (int m = 0; m < 4; ++m) { const int idx = 256 * u.y + rit0 + ai * 128 + m * 16; tk[ai][m] = idx < n_l ? ltok[(size_t)u.x * LCAP + idx] : -1; }
#pragma unroll
        for (int ai = 0; ai < 2; ++ai)
#pragma unroll
            for (int m = 0; m < 4; ++m) { const int tok = tk[ai][m];
                if (tok >= 0) { const bool lat = tok < NLAT;
                    float* xp = lat ? xlat + (size_t)tok * 1024 : xc + (size_t)(tok - NLAT) * 1024; const float* gp = modl + (lat ? (tok >> 13) : 4) * 6144 + 5120;
#pragma unroll
                    for (int bj = 0; bj < 2; ++bj)
#pragma unroll
                        for (int n = 0; n < 2; ++n) { const int c = col0 + bj * 128 + n * 16; const f32x4 gv = *(const f32x4*)(gp + c) * sc; const f32x4 xo = *(const f32x4*)(xp + c); *(f32x4*)(xp + c) = xo + gv * acc[ai][bj][m][n]; } }
                asm volatile("" ::: "memory"); }
    }
};
}

struct Params { const float* in[34]; float* out; unsigned char* ws; };

__device__ __forceinline__ void tr_item(const float* src, int ldsrc, int ksrc0, int nsrc0, bf16_t* dst, int lddst, int ndst0, int kdst0, LAS float* scr, int lane) {
#pragma unroll 8
    for (int i = 0; i < 32; ++i) { const int kk = 2 * i + (lane >> 5); scr[kk * 33 + (lane & 31)] = src ? src[(size_t)(ksrc0 + kk) * ldsrc + nsrc0 + (lane & 31)] : 0.f; }
    LDS_WAIT(); asm volatile("" ::: "memory");
    const int c = lane & 7;
#pragma unroll
    for (int j = 0; j < 4; ++j) { const int n = (lane >> 3) + 8 * j; const LAS float* s = scr + (8 * c) * 33 + n;
        u32x4 o; o.x = f2bf(s[0]) | (f2bf(s[33]) << 16); o.y = f2bf(s[66]) | (f2bf(s[99]) << 16); o.z = f2bf(s[132]) | (f2bf(s[165]) << 16); o.w = f2bf(s[198]) | (f2bf(s[231]) << 16);
        *(u32x4*)(dst + (size_t)(ndst0 + n) * lddst + kdst0 + 8 * c) = o; }
    LDS_WAIT(); asm volatile("" ::: "memory");
}

__device__ __forceinline__ void norm_mod_row(const float* xrow, const float* gain, const float* shift, const float* scale, bf16_t* orow, int lane) {
    const f32x4* xr = (const f32x4*)xrow + lane; f32x4 v[4]; float s = 0.f;
#pragma unroll
    for (int j = 0; j < 4; ++j) { v[j] = xr[64 * j]; s += (v[j].x * v[j].x + v[j].y * v[j].y) + (v[j].z * v[j].z + v[j].w * v[j].w); }
    const float r = 1.0f / sqrtf(wave_sum(s, lane) * (1.0f / DM) + EPSN);
#pragma unroll
    for (int j = 0; j < 4; ++j) { const int c = 4 * lane + 256 * j; const f32x4 g = *(const f32x4*)(gain + c), sh = *(const f32x4*)(shift + c), sc = *(const f32x4*)(scale + c);
        const f32x4 h = (v[j] * r * g) * (sc + 1.0f) + sh;
        u32x2 o; o.x = cvt_pk_bf16(h.x, h.y); o.y = cvt_pk_bf16(h.z, h.w); *(u32x2*)(orow + c) = o; }
}

template <bool LATENT>
__device__ __forceinline__ void attn_tile(const bf16_t* qk, const bf16_t* vt, const bf16_t* vtc, bf16_t* ycat, const LAS float* rpbh, int b, int h, int qrow0, int r, int wt, int lane) {
    const int qi = lane & 15, g = lane >> 4;
    const bf16_t* qp = qk + (size_t)(qrow0 + qi) * 1024 + h * 64 + 8 * g;
    const bf16x8 qf0 = *(const bf16x8*)qp, qf1 = *(const bf16x8*)(qp + 32);
    float m_run = -1e30f, l_run = 0.f; f32x4 o[4];
#pragma unroll
    for (int d = 0; d < 4; ++d) o[d] = (f32x4){0.f, 0.f, 0.f, 0.f};
    const f32x4 z4 = {0.f, 0.f, 0.f, 0.f};
#define ATT_STEP(S0, S1, VB, VSTRIDE) do { \
        float cm = fmaxf(fmaxf(fmaxf(S0[0], S0[1]), fmaxf(S0[2], S0[3])), fmaxf(fmaxf(S1[0], S1[1]), fmaxf(S1[2], S1[3]))); \
        cm = fmaxf(cm, shx<16>(cm, lane)); cm = fmaxf(cm, shx<32>(cm, lane)); \
        const float mn = fmaxf(m_run, cm), al = __expf(m_run - mn); m_run = mn; \
        f32x4 p0, p1; float ps = 0.f; \
        _Pragma("unroll") for (int j = 0; j < 4; ++j) { p0[j] = __expf(S0[j] - mn); p1[j] = __expf(S1[j] - mn); ps += p0[j] + p1[j]; } \
        l_run = l_run * al + ps; \
        union { u32x4 u; bf16x8 v; } pb; pb.u = g8::pack8(p0, p1); \
        _Pragma("unroll") for (int db = 0; db < 4; ++db) { const bf16_t* vp = (VB) + (size_t)(16 * db + qi) * (VSTRIDE); \
            union { u32x4 u; bf16x8 v; } va; const u32x2 lo = *(const u32x2*)vp, hi = *(const u32x2*)(vp + 16); va.u.x = lo.x; va.u.y = lo.y; va.u.z = hi.x; va.u.w = hi.y; \
            o[db] = o[db] * al; o[db] = __builtin_amdgcn_mfma_f32_16x16x32_bf16(va.v, pb.v, o[db], 0, 0, 0); } } while (0)
    if (LATENT) {
        const int kr0 = min(max(r - 4, 0), 120); const int c0 = (wt == 0) ? 0 : (wt == 1 ? 8 : (wt == 2 ? 24 : 32));
        const int wq = 16 * wt + qi, cs = min(max(wq - 8, 0), 48);
#pragma unroll 2
        for (int jr = 0; jr < 8; ++jr) {
            const int kr = kr0 + jr, s0 = kr * 64 + c0;
            const bf16_t* kp = qk + (size_t)(b * 8192 + s0 + qi) * 1024 + 512 + h * 64 + 8 * g;
            const bf16x8 k00 = *(const bf16x8*)kp, k01 = *(const bf16x8*)(kp + 32), k10 = *(const bf16x8*)(kp + 16 * 1024), k11 = *(const bf16x8*)(kp + 16 * 1024 + 32);
            f32x4 sa = __builtin_amdgcn_mfma_f32_16x16x32_bf16(k00, qf0, z4, 0, 0, 0); sa = __builtin_amdgcn_mfma_f32_16x16x32_bf16(k01, qf1, sa, 0, 0, 0);
            f32x4 sb = __builtin_amdgcn_mfma_f32_16x16x32_bf16(k10, qf0, z4, 0, 0, 0); sb = __builtin_amdgcn_mfma_f32_16x16x32_bf16(k11, qf1, sb, 0, 0, 0);
            const LAS float* bp = rpbh + (kr - r + 7) * 31;
#pragma unroll
            for (int j = 0; j < 4; ++j) { const int wk = c0 + 4 * g + j; const int wk2 = wk + 16;
                const bool v0 = (wk >= cs) && (wk < cs + 16), v1 = (wk2 >= cs) && (wk2 < cs + 16);
                const int i0 = min(max(wk - wq + 15, 0), 30), i1 = min(max(wk2 - wq + 15, 0), 30);
                sa[j] = v0 ? sa[j] + bp[i0] : -1e30f; sb[j] = v1 ? sb[j] + bp[i1] : -1e30f; }
            const bf16_t* vb = vt + (size_t)((b * 8 + h) * 64) * 8192 + s0 + 4 * g;
            ATT_STEP(sa, sb, vb, 8192);
        }
    }
#pragma unroll 2
    for (int ch = 0; ch < 8; ++ch) {
        const int j0 = 32 * ch;
        const bf16_t* kp = qk + (size_t)(NLAT + b * 256 + j0 + qi) * 1024 + 512 + h * 64 + 8 * g;
        const bf16x8 k00 = *(const bf16x8*)kp, k01 = *(const bf16x8*)(kp + 32), k10 = *(const bf16x8*)(kp + 16 * 1024), k11 = *(const bf16x8*)(kp + 16 * 1024 + 32);
        f32x4 sa = __builtin_amdgcn_mfma_f32_16x16x32_bf16(k00, qf0, z4, 0, 0, 0); sa = __builtin_amdgcn_mfma_f32_16x16x32_bf16(k01, qf1, sa, 0, 0, 0);
        f32x4 sb = __builtin_amdgcn_mfma_f32_16x16x32_bf16(k10, qf0, z4, 0, 0, 0); sb = __builtin_amdgcn_mfma_f32_16x16x32_bf16(k11, qf1, sb, 0, 0, 0);
        const bf16_t* vb = vtc + (size_t)((b * 8 + h) * 64) * 256 + j0 + 4 * g;
        ATT_STEP(sa, sb, vb, 256);
    }
#undef ATT_STEP
    float l = l_run; l += shx<16>(l, lane); l += shx<32>(l, lane);
    const float inv = 1.0f / l;
    bf16_t* op = ycat + (size_t)(qrow0 + qi) * KCAT + 896 + h * 64 + 4 * g;
#pragma unroll
    for (int db = 0; db < 4; ++db) { u32x2 w; w.x = cvt_pk_bf16(o[db][0] * inv, o[db][1] * inv); w.y = cvt_pk_bf16(o[db][2] * inv, o[db][3] * inv); *(u32x2*)(op + 16 * db) = w; }
}

constexpr int ATT_RING = 16384, ATT_SB = 32768, ATT_NST = 12;
__device__ __forceinline__ void attn_lat_issue(LAS unsigned char* lds, const bf16_t* qk, const bf16_t* vt, const bf16_t* vtc, int T, int nT, int G, int bid, int wave, int lane) {
    const int Tc = T < nT ? T : nT - 1;
    const int ui = Tc / ATT_NST, s = Tc - ui * ATT_NST; const int u = bid + G * ui; const int hp = u & 3, r = (u >> 2) & 127, b = u >> 9;
    const int kr0 = min(max(r - 4, 0), 120);
    LAS unsigned char* slot = lds + ATT_RING + (T & 3) * ATT_SB;
#pragma unroll
    for (int j = 0; j < 4; ++j) {
        const int c = (j * 8 + wave) * 64 + lane;
        const int cc = c & 1023, head = cc >> 9, row = (cc >> 3) & 63, lg = (cc & 7) ^ (row & 7), hh = 2 * hp + head;
        const bf16_t* gp;
        if (j < 2) { const int tok = (s < 8) ? (b * 8192 + (kr0 + s) * 64 + row) : (NLAT + b * 256 + 64 * (s - 8) + row); gp = qk + (size_t)tok * 1024 + 512 + hh * 64 + lg * 8; }
        else { gp = (s < 8) ? (vt + (size_t)((b * 8 + hh) * 64 + row) * 8192 + (kr0 + s) * 64 + lg * 8) : (vtc + (size_t)((b * 8 + hh) * 64 + row) * 256 + 64 * (s - 8) + lg * 8); }
        __builtin_amdgcn_global_load_lds((const unsigned*)gp, (LAS unsigned*)(slot + (j * 8 + wave) * 1024), 16, 0, 0);
    }
}
__device__ __forceinline__ void attn_lat_phase(LAS unsigned char* lds, const bf16_t* qk, const bf16_t* vt, const bf16_t* vtc, bf16_t* ycat, const LAS float* rpbS, int G, int bid, int wave, int lane) {
    const int nunits = (2048 - bid + G - 1) / G; if (nunits <= 0) return;
    const int nT = nunits * ATT_NST;
    const int qi = lane & 15, g = lane >> 4, hl = wave >> 2, wt = wave & 3;
    const int c0 = (wt == 0) ? 0 : (wt == 1 ? 8 : (wt == 2 ? 24 : 32));
    const int wq = 16 * wt + qi, cs = min(max(wq - 8, 0), 48);
    attn_lat_issue(lds, qk, vt, vtc, 0, nT, G, bid, wave, lane); attn_lat_issue(lds, qk, vt, vtc, 1, nT, G, bid, wave, lane); attn_lat_issue(lds, qk, vt, vtc, 2, nT, G, bid, wave, lane);
    int T = 0;
    const f32x4 z4 = {0.f, 0.f, 0.f, 0.f};
    for (int ui = 0; ui < nunits; ++ui) {
        const int u = bid + G * ui; const int hp = u & 3, r = (u >> 2) & 127, b = u >> 9; const int h = 2 * hp + hl;
        const int kr0 = min(max(r - 4, 0), 120); const int qrow = b * 8192 + r * 64 + 16 * wt + qi;
        const bf16_t* qp = qk + (size_t)qrow * 1024 + h * 64 + 8 * g;
        const bf16x8 qf0 = *(const bf16x8*)qp, qf1 = *(const bf16x8*)(qp + 32);
        float m_run = -1e30f, l_run = 0.f; f32x4 o[4];
#pragma unroll
        for (int d = 0; d < 4; ++d) o[d] = (f32x4){0.f, 0.f, 0.f, 0.f};
        const LAS float* rpbh = rpbS + h * 465;
#pragma unroll 1
        for (int s = 0; s < ATT_NST; ++s, ++T) {
            asm volatile("s_waitcnt vmcnt(8)" ::: "memory");
            __builtin_amdgcn_s_barrier();
            asm volatile("" ::: "memory");
            attn_lat_issue(lds, qk, vt, vtc, T + 3, nT, G, bid, wave, lane);
            const LAS unsigned char* Kb = lds + ATT_RING + (T & 3) * ATT_SB + hl * 8192; const LAS unsigned char* Vb = Kb + 16384;
            const int nsub = (s < 8) ? 1 : 2;
            for (int ss = 0; ss < nsub; ++ss) {
                const int kb = (s < 8) ? c0 : 32 * ss;
                f32x4 sa, sb;
                { const int row0 = kb + qi, row1 = row0 + 16;
                  const bf16x8 k00 = *(const LAS bf16x8*)(Kb + row0 * 128 + ((g ^ (row0 & 7)) << 4)), k01 = *(const LAS bf16x8*)(Kb + row0 * 128 + (((4 + g) ^ (row0 & 7)) << 4));
                  const bf16x8 k10 = *(const LAS bf16x8*)(Kb + row1 * 128 + ((g ^ (row1 & 7)) << 4)), k11 = *(const LAS bf16x8*)(Kb + row1 * 128 + (((4 + g) ^ (row1 & 7)) << 4));
                  sa = __builtin_amdgcn_mfma_f32_16x16x32_bf16(k00, qf0, z4, 0, 0, 0); sa = __builtin_amdgcn_mfma_f32_16x16x32_bf16(k01, qf1, sa, 0, 0, 0);
                  sb = __builtin_amdgcn_mfma_f32_16x16x32_bf16(k10, qf0, z4, 0, 0, 0); sb = __builtin_amdgcn_mfma_f32_16x16x32_bf16(k11, qf1, sb, 0, 0, 0); }
                if (s < 8) { const LAS float* bp = rpbh + (kr0 + s - r + 7) * 31;
#pragma unroll
                    for (int j = 0; j < 4; ++j) { const int wk = c0 + 4 * g + j; const int wk2 = wk + 16;
                        const bool v0 = (wk >= cs) && (wk < cs + 16), v1 = (wk2 >= cs) && (wk2 < cs + 16);
                        const int i0 = min(max(wk - wq + 15, 0), 30), i1 = min(max(wk2 - wq + 15, 0), 30);
                        sa[j] = v0 ? sa[j] + bp[i0] : -1e30f; sb[j] = v1 ? sb[j] + bp[i1] : -1e30f; } }
                float cm = fmaxf(fmaxf(fmaxf(sa[0], sa[1]), fmaxf(sa[2], sa[3])), fmaxf(fmaxf(sb[0], sb[1]), fmaxf(sb[2], sb[3])));
                cm = fmaxf(cm, shx<16>(cm, lane)); cm = fmaxf(cm, shx<32>(cm, lane));
                const float mn = fmaxf(m_run, cm), al = __expf(m_run - mn); m_run = mn;
                f32x4 p0, p1; float ps = 0.f;
#pragma unroll
                for (int j = 0; j < 4; ++j) { p0[j] = __expf(sa[j] - mn); p1[j] = __expf(sb[j] - mn); ps += p0[j] + p1[j]; }
                l_run = l_run * al + ps;
                union { u32x4 u; bf16x8 v; } pb; pb.u = g8::pack8(p0, p1);
                const int off = (kb + 4 * g) * 2;
#pragma unroll
                for (int db = 0; db < 4; ++db) { const int d = 16 * db + qi; const LAS unsigned char* vr = Vb + d * 128;
                    const u32x2 lo = *(const LAS u32x2*)(vr + ((((off >> 4) ^ (d & 7)) << 4) | (off & 15))), hi = *(const LAS u32x2*)(vr + (((((off + 32) >> 4) ^ (d & 7)) << 4) | (off & 15)));
                    union { u32x4 u; bf16x8 v; } va; va.u.x = lo.x; va.u.y = lo.y; va.u.z = hi.x; va.u.w = hi.y;
                    o[db] = o[db] * al; o[db] = __builtin_amdgcn_mfma_f32_16x16x32_bf16(va.v, pb.v, o[db], 0, 0, 0); }
            }
        }
        float lsum = l_run; lsum += shx<16>(lsum, lane); lsum += shx<32>(lsum, lane);
        const float inv = 1.0f / lsum;
        bf16_t* op = ycat + (size_t)qrow * KCAT + 896 + h * 64 + 4 * g;
#pragma unroll
        for (int db = 0; db < 4; ++db) { u32x2 w; w.x = cvt_pk_bf16(o[db][0] * inv, o[db][1] * inv); w.y = cvt_pk_bf16(o[db][2] * inv, o[db][3] * inv); *(u32x2*)(op + 16 * db) = w; }
    }
    asm volatile("s_waitcnt vmcnt(0)" ::: "memory");
    __builtin_amdgcn_s_barrier();
}

typedef const __attribute__((address_space(4))) char* KargPtr;
#define INP(i) (*(const float* const volatile __attribute__((address_space(4)))*)(karg + 8 * (i)))
#define WSP(off) (opq(ws) + (off))
#define ctl ((unsigned*)WSP(WS_CTL))
#define mod ((float*)WSP(WS_MOD))
#define ropec ((float*)WSP(WS_ROPE))
#define ropes ((float*)WSP(WS_ROPE + 128 * 16 * 4))
#define s5p ((f32x2*)WSP(WS_S5P))
#define xc ((float*)WSP(WS_XC))
#define ycat ((bf16_t*)WSP(WS_Y))
#define hbuf ycat
#define h2 ycat
#define ebuf ((bf16_t*)WSP(WS_E))
#define ygelu ebuf
#define uvg ((bf16_t*)WSP(WS_UVG))
#define mbuf uvg
#define qk ((bf16_t*)WSP(WS_QK))
#define vt ((bf16_t*)WSP(WS_VT))
#define vtc ((bf16_t*)WSP(WS_VT + 32 * MiB))
#define gates (WSP(WS_G))
#define s5a ((bf16_t*)WSP(WS_S5A))
#define logits ((float*)WSP(WS_LOGITS))
#define ltok ((int*)WSP(WS_LTOK))
#define lw ((float*)WSP(WS_LW))
#define hid ((bf16_t*)WSP(WS_HID))
#define wgu ((bf16_t*)WSP(WS_WGU))
#define wdt ((bf16_t*)WSP(WS_WD))
#define xout (opq(xout_raw))

#define PHASE_IDS() const int lane = opq_v((int)__builtin_amdgcn_mbcnt_hi(~0u, __builtin_amdgcn_mbcnt_lo(~0u, (unsigned)opq_v(0)))); int wave_ = wave0; asm volatile("" : "+s"(wave_)); const int wave = wave_, tid = wave * 64 + lane; \
    const int gw = bid * NWAVES + wave; LAS unsigned char* lds = opq_l(lds0); (void)tid; (void)gw; (void)lds
#define GRID_BAR() do { if constexpr (MULTI) { XcdBarrier b_; b_.bar = (unsigned*)WSP(WS_CTL) + CW_BAR + bli * XCD_BAR_WORDS; b_.x = xb_xcc_id(); b_.st = (volatile LAS unsigned*)(opq_l(lds0) + LDS_MISC); xcd_barrier(b_); } } while (0)
template <unsigned MASK>
__device__ __forceinline__ void layer_body(const int l, KargPtr karg, unsigned char* ws, float* xout_raw, LAS unsigned char* const lds0, const int wave0, const int G, const int bid, const int NGW, const int bli) {
    constexpr bool MULTI = (MASK & (MASK - 1u)) != 0u;
    const int MROWS = (l == 0) ? NROW : NLAT;
#define wb (WSP(WS_WPL) + (size_t)l * WPL_STRIDE)
#define modl (mod + l * 5 * 6144)
        if (PH(2)) REPS(2) { PHASE_IDS(); const float* xl_ = (l == 0 ? INP(0) : (const float*)xout); const float* xc_ = (l == 0 ? INP(2) : (const float*)xc); const float* gn_ = INP(6) + l * 1024; bf16_t* hb_ = hbuf;
          for (int r = gw; r < NROW; r += NGW) {
            const bool lat = r < NLAT; const float* xr = lat ? (xl_ + (size_t)r * 1024) : (xc_ + (size_t)(r - NLAT) * 1024);
            const float* mr = modl + (lat ? (r >> 13) : 4) * 6144;
            norm_mod_row(xr, gn_, mr, mr + 1024, hb_ + (size_t)r * 1024, lane);
          } }
        GRID_BAR();
        if (PH(3)) REPS(3) { PHASE_IDS();
            g8::SchedDense S; S.init(hbuf, wb + WO_WIN, NROW, NWIN, 1024, 1024, G, bid);
            g8::EpiWin E{WSP(0)};
            g8::gemm_run(lds, 1024, 1024, 1024, S, E);
        }
        GRID_BAR();
        if (PH(4)) REPS(4) { PHASE_IDS();
            g8::SchedS5 S{(const char*)s5a, (const char*)(wb + WO_WEND), 256u * 256u * 2u, G, bid};
            g8::EpiS5E E{ebuf};
            g8::gemm_run(lds, 256, 512, 256, S, E);
        }
        if (PH(5)) REPS(5) { PHASE_IDS();
            const int nunits = (l == 0 ? 264 : 256) * 4;
            LAS bf16_t* vnT = (LAS bf16_t*)lds;
            const float* sw = INP(10) + (size_t)l * 4 * 128 * 128; const float* sbias = INP(11) + l * 4 * 128; const float* sgam = INP(9) + l * 512;
            for (int unit = bid; unit < nunits; unit += G) {
                const int ch = unit >> 2, g = unit & 3; const int r0 = 128 * ch;
                {
                    const int p = tid >> 2, qd = tid & 3; const bf16_t* vp = uvg + (size_t)(r0 + p) * 1024 + 512 + 128 * qd; float s = 0.f, s2 = 0.f;
#pragma unroll 4
                    for (int i = 0; i < 16; ++i) { const u32x4 w = *(const u32x4*)(vp + 8 * i);
#pragma unroll
                        for (int j = 0; j < 4; ++j) { const float a = bf2f(w[j] & 0xffffu), b = bf2f(w[j] >> 16); s += a + b; s2 += a * a + b * b; } }
                    s += shx<1>(s, lane); s += shx<2>(s, lane); s2 += shx<1>(s2, lane); s2 += shx<2>(s2, lane);
                    const float mean = s * (1.0f / 512.0f); const float var = fmaxf(s2 * (1.0f / 512.0f) - mean * mean, 0.f); const float rstd = 1.0f / sqrtf(var + EPSN);
                    const bf16_t* gp = uvg + (size_t)(r0 + p) * 1024 + 512 + 128 * g + 32 * qd;
#pragma unroll
                    for (int i = 0; i < 4; ++i) { const u32x4 w = *(const u32x4*)(gp + 8 * i);
#pragma unroll
                        for (int j = 0; j < 4; ++j) { const int c = 32 * qd + 8 * i + 2 * j;
                            vnT[c * 136 + p] = (bf16_t)f2bf((bf2f(w[j] & 0xffffu) - mean) * rstd * sgam[128 * g + c]);
                            vnT[(c + 1) * 136 + p] = (bf16_t)f2bf((bf2f(w[j] >> 16) - mean) * rstd * sgam[128 * g + c + 1]); } }
                }
                __syncthreads();
                {
                    const int qi = lane & 15, gq = lane >> 4; const int q = 16 * wave + qi;
                    bf16x8 wf[4];
#pragma unroll
                    for (int kk = 0; kk < 4; ++kk) { const float* wp = sw + ((size_t)g * 128 + q) * 128 + 32 * kk + 8 * gq; const f32x4 a = *(const f32x4*)wp, b = *(const f32x4*)(wp + 4);
                        union { u32x4 u; bf16x8 v; } t; t.u = g8::pack8(a, b); wf[kk] = t.v; }
                    const float bq = sbias[g * 128 + q];
                    const bf16_t* up = uvg + (size_t)(r0 + q) * 1024 + 128 * g; bf16_t* op = ycat + (size_t)(r0 + q) * KCAT + 128 * g;
#pragma unroll 2
                    for (int cb = 0; cb < 8; ++cb) { f32x4 d = {0.f, 0.f, 0.f, 0.f};
#pragma unroll
                        for (int kk = 0; kk < 4; ++kk) { const bf16x8 af = *(const LAS bf16x8*)(vnT + (16 * cb + qi) * 136 + 32 * kk + 8 * gq); d = __builtin_amdgcn_mfma_f32_16x16x32_bf16(af, wf[kk], d, 0, 0, 0); }
                        const int c = 16 * cb + 4 * gq; const u32x2 uu = *(const u32x2*)(up + c); u32x2 w;
                        w.x = cvt_pk_bf16(bf2f(uu.x & 0xffffu) * (d[0] + bq), bf2f(uu.x >> 16) * (d[1] + bq)); w.y = cvt_pk_bf16(bf2f(uu.y & 0xffffu) * (d[2] + bq), bf2f(uu.y >> 16) * (d[3] + bq));
                        *(u32x2*)(op + c) = w; }
                }
                __syncthreads();
            }
        }
        GRID_BAR();
        if (PH(6)) REPS(6) { PHASE_IDS();
            LAS float* rpbS = (LAS float*)lds;
            { const float* rp_ = INP(21) + (size_t)l * 8 * 465; for (int i = tid; i < 8 * 465; i += NTHR) rpbS[i] = rp_[i]; }
            __syncthreads();
            if (bid < 192) {
                const int b = bid / 48, g = (bid % 48) >> 1, dir = bid & 1;
                const f32x2 lam16 = s5p[(size_t)((l * 2 + dir) * 24 + g) * 3136 + 16 * 64 + lane];
                const bf16_t* eb = ebuf + (size_t)g * S5R * 256 + dir * 128 + lane; bf16_t* cb = s5a + (size_t)g * S5R * 512 + 256 + dir * 128 + lane;
                LAS f32x2* segT = (LAS f32x2*)(lds + 16384);
                float cr = 0.f, ci = 0.f, dr = 1.f, di = 0.f;
                for (int jb = 0; jb < 66; jb += 22) { float er[22], ei[22];
#pragma unroll
                    for (int j = 0; j < 22; ++j) { const int k = 66 * wave + jb + j; const int R = (k < 16) ? (2048 + 16 * b + (dir ? 15 - k : k)) : (512 * b + (dir ? 527 - k : k - 16));
                        er[j] = bf2f(eb[(size_t)R * 256]); ei[j] = bf2f(eb[(size_t)R * 256 + 64]); }
#pragma unroll
                    for (int j = 0; j < 22; ++j) { const float nr = lam16.x * cr - lam16.y * ci + er[j], ni = lam16.x * ci + lam16.y * cr + ei[j]; cr = nr; ci = ni;
                        const float tr = dr * lam16.x - di * lam16.y, ti = dr * lam16.y + di * lam16.x; dr = tr; di = ti; } }
                segT[wave * 64 + lane] = (f32x2){cr, ci};
                __syncthreads();
                float ar = 0.f, ai = 0.f;
                for (int s = 0; s < wave; ++s) { const f32x2 t = segT[s * 64 + lane]; const float nr = dr * ar - di * ai + t.x, ni = dr * ai + di * ar + t.y; ar = nr; ai = ni; }
                for (int jb = 0; jb < 66; jb += 22) { float er[22], ei[22];
#pragma unroll
                    for (int j = 0; j < 22; ++j) { const int k = 66 * wave + jb + j; const int R = (k < 16) ? (2048 + 16 * b + (dir ? 15 - k : k)) : (512 * b + (dir ? 527 - k : k - 16));
                        er[j] = bf2f(eb[(size_t)R * 256]); ei[j] = bf2f(eb[(size_t)R * 256 + 64]); }
#pragma unroll
                    for (int j = 0; j < 22; ++j) { const int k = 66 * wave + jb + j; const int R = (k < 16) ? (2048 + 16 * b + (dir ? 15 - k : k)) : (512 * b + (dir ? 527 - k : k - 16));
                        cb[(size_t)R * 512] = (bf16_t)f2bf(ar); cb[(size_t)R * 512 + 64] = (bf16_t)f2bf(ai);
                        const float nr = lam16.x * ar - lam16.y * ai + er[j], ni = lam16.x * ai + lam16.y * ar + ei[j]; ar = nr; ai = ni; } }
            }
            __syncthreads();
            if (l == 0) for (int u2 = gw; u2 < 512; u2 += NGW) { const int qt = u2 & 15, h = (u2 >> 4) & 7, b = u2 >> 7;
                attn_tile<false>(qk, vt, vtc, ycat, rpbS, b, h, NLAT + b * 256 + 16 * qt, 0, 0, (int)__builtin_amdgcn_mbcnt_hi(~0u, __builtin_amdgcn_mbcnt_lo(~0u, (unsigned)opq_v(0)))); }
            attn_lat_phase(lds, qk, vt, vtc, ycat, rpbS, G, bid, wave, (int)__builtin_amdgcn_mbcnt_hi(~0u, __builtin_amdgcn_mbcnt_lo(~0u, (unsigned)opq_v(0))));
        }
        GRID_BAR();
        if (PH(7)) REPS(7) { PHASE_IDS();
            g8::SchedS5 S{(const char*)s5a, (const char*)(wb + WO_KT), 256u * 512u * 2u, G, bid};
            g8::EpiS5Y E{ygelu};
            g8::gemm_run(lds, 512, 512, 512, S, E);
        }
        GRID_BAR();
        if (PH(8)) REPS(8) { PHASE_IDS();
            g8::SchedDense S; S.init(ygelu, wb + WO_GLU, MROWS, 512, 384, 384, G, bid);
            g8::EpiGlu E{ygelu, ycat};
            g8::gemm_run(lds, 384, 384, 384, S, E);
        }
        GRID_BAR();
        if (PH(9)) REPS(9) { PHASE_IDS();
            { g8::SchedDense S; S.init(ycat, wb + WO_WCAT, MROWS, 1024, KCAT, KCAT, G, bid); g8::EpiMerge E{gates, mbuf, 0}; g8::gemm_run(lds, 512, KCAT, KCAT, S, E); }
            { g8::SchedDense S; S.init(ycat + 512, wb + WO_WCAT + 512 * 2, MROWS, 1024, KCAT, KCAT, G, bid); g8::EpiMerge E{gates, mbuf, 1}; g8::gemm_run(lds, 384, KCAT, KCAT, S, E); }
            { g8::SchedDense S; S.init(ycat + 896, wb + WO_WCAT + 896 * 2, MROWS, 1024, KCAT, KCAT, G, bid); g8::EpiMerge E{gates, mbuf, 2}; g8::gemm_run(lds, 512, KCAT, KCAT, S, E); }
        }
        GRID_BAR();
        if (PH(10)) REPS(10) { PHASE_IDS();
            g8::SchedDense S; S.init(mbuf, wb + WO_WOUT, MROWS, 1024, 1024, 1024, G, bid);
            g8::EpiWout E{(l == 0 && rep_ == 0) ? INP(0) : (const float*)xout, (l == 0 && rep_ == 0) ? INP(2) : (const float*)xc, xout, xc, modl, rep_ == 0 ? 1.f : 0.f};
            g8::gemm_run(lds, 1024, 1024, 1024, S, E);
        }
        GRID_BAR();
        if (PH(11)) REPS(11) { PHASE_IDS(); const float* xl_ = xout; const float* xc_ = xc; const float* gn_ = INP(7) + l * 1024; bf16_t* hb_ = h2;
          for (int r = gw; r < MROWS; r += NGW) {
            const bool lat = r < NLAT; const float* xr = lat ? (xl_ + (size_t)r * 1024) : (xc_ + (size_t)(r - NLAT) * 1024);
            const float* mr = modl + (lat ? (r >> 13) : 4) * 6144;
            norm_mod_row(xr, gn_, mr + 3072, mr + 4096, hb_ + (size_t)r * 1024, lane);
          } }
        if (PH(11)) REPS(11) { PHASE_IDS();
            LAS float* scr = (LAS float*)(lds + wave * 8448);
            for (int it = gw; it < 32 * 384; it += NGW) { const int e = it / 384; int r = it % 384;
                if (r < 256) { const int up = r >> 7; r &= 127; const int kb = r >> 3, nb = r & 7, n0 = 32 * nb;
                    tr_item((up ? INP(31) : INP(30)) + ((size_t)(l * 32 + e) * 1024) * 256, 256, 64 * kb, n0, wgu + (size_t)e * 512 * 1024, 1024, 256 * (n0 >> 7) + 128 * up + (n0 & 127), 64 * kb, scr, lane); }
                else { r -= 256; const int kb = r >> 5, nb = r & 31; tr_item(INP(32) + ((size_t)(l * 32 + e) * 256) * 1024, 1024, 64 * kb, 32 * nb, wdt + (size_t)e * 1024 * 256, 256, 32 * nb, 64 * kb, scr, lane); }
            }
        }
        GRID_BAR();
        if (PH(12)) REPS(12) { PHASE_IDS();
            g8::SchedDense S; S.init(h2, wb + WO_WR, MROWS, 256, 1024, 1024, G, bid);
            g8::EpiLogits E{logits};
            g8::gemm_run(lds, 1024, 1024, 1024, S, E);
        }
        GRID_BAR();
        if (PH(13)) { PHASE_IDS();
            unsigned* cntg = ctl + CW_CNT + l * 64 * 32; const float* rgb = INP(27) + l * 4; const float* reb = INP(29) + l * 32; const float* lg_ = logits; int* lt_ = ltok; float* lw_ = lw;
            LAS unsigned* hist = (LAS unsigned*)lds; LAS unsigned* lbase = hist + 64;
            if (tid < 64) hist[tid] = 0u;
            __syncthreads();
            const int per = (MROWS + G - 1) / G; const int r = bid * per + tid; const bool act = tid < per && r < MROWS;
            int L0 = 0, L1 = 0; unsigned s0 = 0, s1 = 0; float cw0 = 0.f, cw1 = 0.f;
            if (act) {
                const float* lp = lg_ + (size_t)r * 128; float v[72];
#pragma unroll
                for (int i = 0; i < 18; ++i) { const f32x4 t = *(const f32x4*)(lp + 4 * i); v[4 * i] = t.x; v[4 * i + 1] = t.y; v[4 * i + 2] = t.z; v[4 * i + 3] = t.w; }
                float lg[4]; int grp = 0; float gmax;
#pragma unroll
                for (int j = 0; j < 4; ++j) lg[j] = v[j] + v[36 + j] + rgb[j];
                gmax = lg[0];
#pragma unroll
                for (int j = 1; j < 4; ++j) if (lg[j] > gmax) { gmax = lg[j]; grp = j; }
                float gs = 0.f;
#pragma unroll
                for (int j = 0; j < 4; ++j) gs += __expf(lg[j] - gmax);
                const float gwt = 1.0f / gs;
                float le[8];
#pragma unroll
                for (int j = 0; j < 8; ++j) { float a = 0.f;
#pragma unroll
                    for (int q = 0; q < 4; ++q) a = (grp == q) ? (v[4 + 8 * q + j] + v[40 + 8 * q + j]) : a;
                    le[j] = a + reb[8 * grp + j]; }
                int i1 = 0; float v1 = le[0];
#pragma unroll
                for (int j = 1; j < 8; ++j) if (le[j] > v1) { v1 = le[j]; i1 = j; }
                int i2 = -1; float v2 = -3.4e38f;
#pragma unroll
                for (int j = 0; j < 8; ++j) if (j != i1 && le[j] > v2) { v2 = le[j]; i2 = j; }
                const float e2 = __expf(v2 - v1); const float w1 = 1.0f / (1.0f + e2), w2 = e2 * w1;
                L0 = 8 * grp + i1; L1 = 32 + 8 * grp + i2; cw0 = gwt * w1; cw1 = gwt * w2;
                s0 = __hip_atomic_fetch_add(hist + L0, 1u, __ATOMIC_RELAXED, __HIP_MEMORY_SCOPE_WORKGROUP); s1 = __hip_atomic_fetch_add(hist + L1, 1u, __ATOMIC_RELAXED, __HIP_MEMORY_SCOPE_WORKGROUP);
            }
            __syncthreads();
            if (tid < 64) { const unsigned c = hist[tid]; lbase[tid] = c ? atomicAdd(cntg + tid * 32, c) : 0u; }
            __syncthreads();
            if (act) { const unsigned p0 = lbase[L0] + s0, p1 = lbase[L1] + s1;
                lt_[(size_t)L0 * LCAP + p0] = r; lw_[(size_t)L0 * LCAP + p0] = cw0;
                lt_[(size_t)L1 * LCAP + p1] = r; lw_[(size_t)L1 * LCAP + p1] = cw1; }
        }
        GRID_BAR();
#define MOE_TABLES() LAS int* tstart = (LAS int*)(lds + LDS_MISC) + 16; LAS int* lcnt = (LAS int*)(lds + LDS_MISC) + 96; \
            if (tid < 64) lcnt[tid] = (int)__hip_atomic_load(ctl + CW_CNT + (l * 64 + tid) * 32, __ATOMIC_RELAXED, __HIP_MEMORY_SCOPE_AGENT); \
            __syncthreads(); \
            if (tid == 0) { int s = 0; for (int j = 0; j < 64; ++j) { tstart[j] = s; s += (lcnt[j] + 255) >> 8; } tstart[64] = s; } \
            __syncthreads()
        if (PH(14)) REPS(14) { PHASE_IDS(); MOE_TABLES();
            g8::SchedMoeUp S{(const char*)h2, (const char*)wgu, ltok, tstart, lcnt, G, bid};
            g8::EpiMoeUp E{hid, lw, lcnt};
            g8::gemm_run(lds, 1024, 1024, 1024, S, E);
        }
        GRID_BAR();
        if (PH(15)) REPS(15) { PHASE_IDS(); MOE_TABLES();
            g8::SchedMoeDown S{(const char*)hid, (const char*)wdt, tstart, 0, G, bid};
            g8::EpiMoeDown E{xout, xc, mod + l * 5 * 6144, ltok, lcnt, rep_ == 0 ? 1.f : 0.f};
            g8::gemm_run(lds, 256, 256, 256, S, E);
        }
        GRID_BAR();
        if (PH(16)) REPS(16) { PHASE_IDS(); MOE_TABLES();
            g8::SchedMoeDown S{(const char*)hid, (const char*)wdt, tstart, 1, G, bid};
            g8::EpiMoeDown E{xout, xc, mod + l * 5 * 6144, ltok, lcnt, rep_ == 0 ? 1.f : 0.f};
            g8::gemm_run(lds, 256, 256, 256, S, E);
        }
        GRID_BAR();
}

template <unsigned MASK>
__global__ void __launch_bounds__(NTHR, 2) hybrid_fwd(Params P, int l0, int l1, int bli) {
    constexpr bool MULTI = (MASK & (MASK - 1u)) != 0u;
    extern __shared__ __attribute__((aligned(16))) unsigned char lds_raw[];
    LAS unsigned char* const lds0 = (LAS unsigned char*)lds_raw; LAS unsigned char* lds = lds0;
    volatile LAS unsigned* MISC = (volatile LAS unsigned*)(lds + LDS_MISC);
    const int tid = threadIdx.x, lane = tid & 63, wave = __builtin_amdgcn_readfirstlane(tid >> 6);
    const int G = gridDim.x, bid = blockIdx.x;
    const int gw = bid * NWAVES + wave, NGW = G * NWAVES;
    KargPtr karg = (KargPtr)__builtin_amdgcn_kernarg_segment_ptr();
    unsigned char* ws = *(unsigned char* const volatile __attribute__((address_space(4)))*)(karg + 8 * 35);
    for (int u = tid; u < 256; u += NTHR) MISC[u] = 0u;
    __syncthreads();
    if constexpr (MULTI) (void)xcd_barrier_post((unsigned*)(ws + WS_CTL) + CW_BAR + bli * XCD_BAR_WORDS, MISC);
    const int wave0 = wave;

    float* xout_raw = *(float* const volatile __attribute__((address_space(4)))*)(karg + 8 * 34);

    if (PH(0)) REPS(0) {
        LAS float* scr = (LAS float*)(lds + wave * 8448);
        constexpr int IT_WIN = 16 * 192, IT_A = 8 * 32, IT_B = 6 * 32, IT_C = 8 * 32, IT_O = 16 * 32, IT_G = 6 * 16, IT_L = IT_WIN + IT_A + IT_B + IT_C + IT_O + IT_G;
        for (int it = gw; it < 2 * IT_L; it += NGW) {
            const int l = it / IT_L; int r = it % IT_L; unsigned char* wbp = ws + WS_WPL + (size_t)l * WPL_STRIDE;
            if (r < IT_WIN) { const int kb = r / 192, nb = r % 192, n0 = 32 * nb; int src = -1;
                if (n0 < 1024) src = n0; else if (n0 < 2560) src = 1408 + (n0 - 1024); else if (n0 < 5632) src = 2944 + (n0 - 2560); else if (n0 < 6016) src = 1024 + (n0 - 5632);
                tr_item(src >= 0 ? INP(8) + (size_t)l * 1024 * 6016 : nullptr, 6016, 64 * kb, src, (bf16_t*)(wbp + WO_WIN), 1024, n0, 64 * kb, scr, lane); continue; } r -= IT_WIN;
            if (r < IT_A) { tr_item(INP(22) + (size_t)l * 512 * 1024, 1024, 64 * (r / 32), 32 * (r % 32), (bf16_t*)(wbp + WO_WCAT), KCAT, 32 * (r % 32), 64 * (r / 32), scr, lane); continue; } r -= IT_A;
            if (r < IT_B) { tr_item(INP(23) + (size_t)l * 384 * 1024, 1024, 64 * (r / 32), 32 * (r % 32), (bf16_t*)(wbp + WO_WCAT), KCAT, 32 * (r % 32), 512 + 64 * (r / 32), scr, lane); continue; } r -= IT_B;
            if (r < IT_C) { tr_item(INP(24) + (size_t)l * 512 * 1024, 1024, 64 * (r / 32), 32 * (r % 32), (bf16_t*)(wbp + WO_WCAT), KCAT, 32 * (r % 32), 896 + 64 * (r / 32), scr, lane); continue; } r -= IT_C;
            if (r < IT_O) { tr_item(INP(25) + (size_t)l * 1024 * 1024, 1024, 64 * (r / 32), 32 * (r % 32), (bf16_t*)(wbp + WO_WOUT), 1024, 32 * (r % 32), 64 * (r / 32), scr, lane); continue; } r -= IT_O;
            { const int kb = r / 16, nb = r % 16; tr_item(nb < 12 ? INP(20) + (size_t)l * 384 * 384 : nullptr, 384, 64 * kb, 32 * nb, (bf16_t*)(wbp + WO_GLU), 384, 32 * nb, 64 * kb, scr, lane); }
        }
        const float* rgw = INP(26); const float* rew = INP(28);
        for (int idx = bid * NTHR + tid; idx < 2 * 256 * 1024; idx += G * NTHR) {
            const int l = idx >> 18, n = (idx >> 10) & 255, k = idx & 1023; float w = 0.f; int lo = 0, j = n;
            if (n >= 36 && n < 72) { lo = 1; j = n - 36; }
            if (n < 72) w = j < 4 ? rgw[(size_t)l * 1024 * 4 + k * 4 + j] : rew[(size_t)l * 1024 * 32 + k * 32 + (j - 4)];
            const unsigned hb = f2bf(w); const float res = lo ? (w - bf2f(hb)) : 0.f;
            ((bf16_t*)(ws + WS_WPL + (size_t)l * WPL_STRIDE + WO_WR))[n * 1024 + k] = (bf16_t)(lo ? f2bf(res) : hb);
        }
        for (int idx = bid * NTHR + tid; idx < 128 * 16; idx += G * NTHR) {
            const int pos = idx >> 4, f = idx & 15; const float inv = powf(10000.0f, -(float)f / 16.0f); const float ang = (float)pos * inv;
            ropec[idx] = cosf(ang); ropes[idx] = sinf(ang);
        }
        const float* s5bre = INP(15); const float* s5bim = INP(16); const float* s5cre = INP(17); const float* s5cim = INP(18);
        for (int idx = bid * NTHR + tid; idx < 2 * 2 * 24 * 64; idx += G * NTHR) {
            const int p = idx & 63, ldg = idx >> 6;
            const float are = INP(12)[idx], aim = INP(13)[idx]; const float dt = expf(INP(14)[ldg]);
            const float zr = are * dt, zi = aim * dt;
            f32x2* base = s5p + (size_t)ldg * 3136;
            for (int d = 0; d <= 16; ++d) { const float e = expf(zr * (float)d); base[d * 64 + p] = (f32x2){e * cosf(zi * (float)d), e * sinf(zi * (float)d)}; }
            const float e1 = expf(zr), lr = e1 * cosf(zi) - 1.0f, li = e1 * sinf(zi); const float den = 1.0f / (are * are + aim * aim);
            const float cr = (lr * are + li * aim) * den, ci = (li * are - lr * aim) * den;
            for (int c = 0; c < 16; ++c) { const float br = s5bre[(size_t)idx * 16 + c], bi = s5bim[(size_t)idx * 16 + c];
                base[1088 + p * 16 + c] = (f32x2){cr * br - ci * bi, cr * bi + ci * br};
                base[2112 + c * 64 + p] = (f32x2){s5cre[((size_t)ldg * 16 + c) * 64 + p], s5cim[((size_t)ldg * 16 + c) * 64 + p]}; }
        }
        __syncthreads();
        for (int unit = bid; unit < 2 * 96; unit += G) {
            const int l = unit / 96, n0 = 64 * (unit % 96);
            LAS float* sv = (LAS float*)lds; LAS float* part = sv + 5 * 1024;
            const float* cv = INP(1); const float* ccv = INP(3);
            for (int i = tid; i < 5 * 1024; i += NTHR) { const int m = i >> 10, k = i & 1023; const float c = m < 4 ? cv[m * 1024 + k] : ccv[k]; sv[i] = c * sigmoidf_(c); }
            __syncthreads();
            float a[5] = {0.f, 0.f, 0.f, 0.f, 0.f};
            const float* wp = INP(4) + (size_t)l * 1024 * 6144 + n0 + lane;
#pragma unroll 4
            for (int k = wave * 128; k < wave * 128 + 128; ++k) { const float w = wp[(size_t)k * 6144];
#pragma unroll
                for (int m = 0; m < 5; ++m) a[m] += sv[m * 1024 + k] * w; }
#pragma unroll
            for (int m = 0; m < 5; ++m) part[(wave * 5 + m) * 64 + lane] = a[m];
            __syncthreads();
            if (tid < 320) { const int m = tid >> 6, n = tid & 63; float s = 0.f;
#pragma unroll
                for (int w = 0; w < 8; ++w) s += part[(w * 5 + m) * 64 + n];
                mod[(l * 5 + m) * 6144 + n0 + n] = s + INP(5)[l * 6144 + n0 + n]; }
            __syncthreads();
        }
    }
    GRID_BAR();
    if (PH(1)) REPS(1) for (int unit = bid; unit < 192; unit += G) {
        const int l = unit / 96, g = (unit % 96) >> 2, qt = unit & 3;
        LAS f32x2* prm = (LAS f32x2*)lds;
        LAS float* Gt = (LAS float*)(lds + 2 * 3136 * 8);
        { const f32x2* pf = s5p + (size_t)((l * 2 + 0) * 24 + g) * 3136; const f32x2* pr = s5p + (size_t)((l * 2 + 1) * 24 + g) * 3136;
          for (int i = tid; i < 3136; i += NTHR) { prm[i] = pf[i]; prm[3136 + i] = pr[i]; } }
        __syncthreads();
        for (int e = tid; e < 2048; e += NTHR) { const int dir = e >> 10, d = (e >> 6) & 15, co = 4 * qt + ((e >> 4) & 3), ci = e & 15; const LAS f32x2* pp = prm + dir * 3136; float s = 0.f;
#pragma unroll 8
            for (int p = 0; p < 64; ++p) { const f32x2 c = pp[2112 + co * 64 + p], w = pp[d * 64 + p], bb = pp[1088 + p * 16 + ci];
                const float tr = c.x * w.x - c.y * w.y, ti = c.x * w.y + c.y * w.x; s += tr * bb.x - ti * bb.y; }
            Gt[e] = s; }
        __syncthreads();
        unsigned* kt = (unsigned*)((bf16_t*)(ws + WS_WPL + (size_t)l * WPL_STRIDE + WO_KT) + (size_t)g * 256 * 512);
        unsigned* we = (unsigned*)((bf16_t*)(ws + WS_WPL + (size_t)l * WPL_STRIDE + WO_WEND) + (size_t)g * 256 * 256);
        const float* s5d = INP(19) + l * 384 + 16 * g;
        for (int idx = tid; idx < 64 * 256; idx += NTHR) { const int rr = idx >> 8, k0 = (idx & 255) * 2, m = rr >> 2, cq = rr & 3, co = 4 * qt + cq, n = 16 * m + co; float v[2];
#pragma unroll
            for (int j = 0; j < 2; ++j) { const int k = k0 + j; float x = 0.f;
                if (k < 256) { const int mp = k >> 4, ci = k & 15;
                    if (mp <= m) x += Gt[(((m - mp) * 4 + cq) * 16) + ci];
                    if (mp >= m) x += Gt[1024 + (((mp - m) * 4 + cq) * 16) + ci];
                    if (mp == m && co == ci) x += s5d[co];
                } else { const int q = (k - 256) & 127, dir = (k - 256) >> 7, p = q & 63, im = q >> 6; const LAS f32x2* pp = prm + dir * 3136;
                    const f32x2 c = pp[2112 + co * 64 + p], w = pp[(dir ? (16 - m) : (m + 1)) * 64 + p];
                    x = im ? -(c.x * w.y + c.y * w.x) : (c.x * w.x - c.y * w.y); }
                v[j] = x; }
            kt[(n * 512 + k0) >> 1] = f2bf(v[0]) | (f2bf(v[1]) << 16); }
        for (int idx = tid; idx < 64 * 128; idx += NTHR) { const int n = 64 * qt + (idx >> 7), k0 = (idx & 127) * 2, dir = n >> 7, p = n & 63, im = (n >> 6) & 1; const LAS f32x2* pp = prm + dir * 3136; float v[2];
#pragma unroll
            for (int j = 0; j < 2; ++j) { const int k = k0 + j, mp = k >> 4, ci = k & 15; const f32x2 w = pp[(dir ? mp : (15 - mp)) * 64 + p], bb = pp[1088 + p * 16 + ci];
                v[j] = im ? (w.x * bb.y + w.y * bb.x) : (w.x * bb.x - w.y * bb.y); }
            we[(n * 256 + k0) >> 1] = f2bf(v[0]) | (f2bf(v[1]) << 16); }
        __syncthreads();
    }

    if constexpr (MASK == ALL_PHASES) { layer_body<MASK>(0, karg, ws, xout_raw, lds0, wave, G, bid, NGW, bli); layer_body<MASK>(1, karg, ws, xout_raw, lds0, wave, G, bid, NGW, bli); }
    else { for (int l = l0; l < l1; ++l) layer_body<MASK>(l, karg, ws, xout_raw, lds0, wave, G, bid, NGW, bli); }
#ifdef EXTRA_BARS
    for (int i_ = 0; i_ < EXTRA_BARS; ++i_) GRID_BAR();
#endif
    if (PH(17)) { PHASE_IDS(); const float* fg_ = INP(33); float* xo_ = xout;
    for (int r = gw; r < NLAT; r += NGW) {
        float* xr = xo_ + (size_t)r * 1024; f32x4* xp = (f32x4*)xr + lane; f32x4 v[4]; float s = 0.f;
#pragma unroll
        for (int j = 0; j < 4; ++j) { v[j] = xp[64 * j]; s += (v[j].x * v[j].x + v[j].y * v[j].y) + (v[j].z * v[j].z + v[j].w * v[j].w); }
        const float rr = 1.0f / sqrtf(wave_sum(s, lane) * (1.0f / DM) + EPSN);
#pragma unroll
        for (int j = 0; j < 4; ++j) { const f32x4 g = *(const f32x4*)(fg_ + 4 * lane + 256 * j); xp[64 * j] = v[j] * rr * g; }
    } }
}

template <unsigned MASK> static void launch_ph(const Params& p, int l0, int l1, int grid, hipStream_t s) {
    static bool attr = false;
    if (!attr) { if (hipFuncSetAttribute((const void*)hybrid_fwd<MASK>, hipFuncAttributeMaxDynamicSharedMemorySize, LDS_BYTES) != hipSuccess) fprintf(stderr, "kernel_launch: hipFuncSetAttribute failed\n"); attr = true; }
    hipLaunchKernelGGL(hybrid_fwd<MASK>, dim3(grid), dim3(NTHR), LDS_BYTES, s, p, l0, l1, 0);
}
extern "C" void kernel_launch(void* const* d_in, const int* in_sizes, int n_in, void* d_out, int out_size, void* d_ws, size_t ws_size, hipStream_t stream) {
    static int grid = 0;
    if (grid == 0) {
        if (n_in != 34 || out_size != NLAT * DM || ws_size < WS_END) { fprintf(stderr, "kernel_launch: unexpected problem (n_in %d, out %d, ws %zu)\n", n_in, out_size, ws_size); grid = -1; return; }
        int dev = 0, cus = 0;
        if (hipGetDevice(&dev) != hipSuccess || hipDeviceGetAttribute(&cus, hipDeviceAttributeMultiprocessorCount, dev) != hipSuccess) { grid = -1; return; }
        grid = cus;
    }
    if (grid < 0) return;
    (void)hipMemsetAsync((char*)d_ws + WS_CTL, 0, CTL_BYTES, stream);
    Params p{};
    for (int i = 0; i < 34; ++i) p.in[i] = (const float*)d_in[i];
    p.out = (float*)d_out; p.ws = (unsigned char*)d_ws;
#if N_LAUNCHES == 1
    {
        static bool q = false;
        if (!q) { q = true; int per_cu = 0; (void)hipFuncSetAttribute((const void*)hybrid_fwd<ALL_PHASES>, hipFuncAttributeMaxDynamicSharedMemorySize, LDS_BYTES);
            if (hipOccupancyMaxActiveBlocksPerMultiprocessor(&per_cu, (const void*)hybrid_fwd<ALL_PHASES>, NTHR, LDS_BYTES) != hipSuccess || per_cu < 1) fprintf(stderr, "kernel_launch: occupancy query says %d\n", per_cu);
            (void)hipGetLastError(); }
    }
    launch_ph<ALL_PHASES>(p, 0, 2, grid, stream);
#else
    launch_ph<1u << 0>(p, 0, 0, grid, stream);
    launch_ph<1u << 1>(p, 0, 0, grid, stream);
    for (int l = 0; l < 2; ++l) {
        launch_ph<1u << 2>(p, l, l + 1, grid, stream);  launch_ph<1u << 3>(p, l, l + 1, grid, stream);  launch_ph<1u << 4>(p, l, l + 1, grid, stream);
        launch_ph<1u << 5>(p, l, l + 1, grid, stream);  launch_ph<1u << 6>(p, l, l + 1, grid, stream);  launch_ph<1u << 7>(p, l, l + 1, grid, stream);
        launch_ph<1u << 8>(p, l, l + 1, grid, stream);  launch_ph<1u << 9>(p, l, l + 1, grid, stream);  launch_ph<1u << 10>(p, l, l + 1, grid, stream);
        launch_ph<1u << 11>(p, l, l + 1, grid, stream); launch_ph<1u << 12>(p, l, l + 1, grid, stream); launch_ph<1u << 13>(p, l, l + 1, grid, stream);
        launch_ph<1u << 14>(p, l, l + 1, grid, stream); launch_ph<1u << 15>(p, l, l + 1, grid, stream); launch_ph<1u << 16>(p, l, l + 1, grid, stream);
    }
    launch_ph<1u << 17>(p, 0, 0, grid, stream);
#endif
}
```

```cpp
#include <hip/hip_runtime.h>
#include <cstdio>
#include <cstdint>

#define LAS __attribute__((address_space(3)))
typedef unsigned short bf16_t;
typedef short bf16x8 __attribute__((ext_vector_type(8)));
typedef float f32x4 __attribute__((ext_vector_type(4)));
typedef float f32x2 __attribute__((ext_vector_type(2)));
typedef unsigned u32x4 __attribute__((ext_vector_type(4)));
typedef unsigned u32x2 __attribute__((ext_vector_type(2)));

#ifndef N_LAUNCHES
#define N_LAUNCHES 1
#endif
#define PH(k) ((MASK >> (k)) & 1u)
#ifndef DUP_MASK
#define DUP_MASK 0u
#endif
#ifndef PROBE_MASK
#define PROBE_MASK 0u
#endif
#define PROBE_ON(k) (((((unsigned)PROBE_MASK) >> (k)) & 1u) != 0u)
#define PROBE_T0(k) unsigned long long pt0_ = 0; if (PROBE_ON(k) && bid == 0 && wave0 == 0) pt0_ = __builtin_amdgcn_s_memrealtime()
#define PROBE_T1(k) if (PROBE_ON(k) && bid == 0 && wave0 == 0) { const unsigned long long d_ = __builtin_amdgcn_s_memrealtime() - pt0_; if (__builtin_amdgcn_mbcnt_hi(~0u, __builtin_amdgcn_mbcnt_lo(~0u, 0u)) == 0) { unsigned long long* pa_ = (unsigned long long*)(WSP(WS_CTL) + 4096); *pa_ += d_; } }
#define REPS(k) for (int rep_ = 0; rep_ < 1 + (int)((((unsigned)DUP_MASK) >> (k)) & 1u); ++rep_)
constexpr unsigned ALL_PHASES = 0x3ffffu;

constexpr int DM = 1024, SEQ = 8192, CTXL = 256, NLAT = 32768, NCTX = 1024, NROW = 33792;
constexpr int NWIN = 6144, KCAT = 1408, S5R = 2304, S5RV = 2112, LCAP = 33792;
constexpr float EPSN = 1e-6f;
constexpr int NWAVES = 8, NTHR = 512;

constexpr size_t MiB = 1u << 20;
constexpr size_t WS_CTL = 0, CTL_BYTES = MiB;
constexpr size_t WS_MOD = 1 * MiB;
constexpr size_t WS_ROPE = 1 * MiB + 256 * 1024;
constexpr size_t WS_S5P = 2 * MiB;
constexpr size_t WS_WPL = 6 * MiB, WPL_STRIDE = 27 * MiB;
constexpr size_t WO_WIN = 0, WO_WCAT = 12 * MiB, WO_WOUT = 15 * MiB, WO_WR = 17 * MiB, WO_GLU = 17 * MiB + 512 * 1024, WO_KT = 18 * MiB, WO_WEND = 24 * MiB;
constexpr size_t WS_XC = 60 * MiB;
constexpr size_t WS_Y = 64 * MiB;
constexpr size_t WS_E = 155 * MiB;
constexpr size_t WS_UVG = 182 * MiB;
constexpr size_t WS_QK = 248 * MiB;
constexpr size_t WS_VT = 314 * MiB;
constexpr size_t WS_G = 347 * MiB;
constexpr size_t WS_S5A = 446 * MiB;
constexpr size_t WS_END = 500 * MiB;
constexpr size_t WS_LOGITS = WS_QK, WS_LTOK = WS_QK + 20 * MiB, WS_LW = WS_QK + 30 * MiB;
constexpr size_t WS_HID = WS_G, WS_WGU = WS_G + 42 * MiB, WS_WD = WS_G + 74 * MiB;
constexpr int CW_BAR = 4096, CW_CNT = 8192;

constexpr int LDS_STAGE = 131072, LDS_BYTES = 155648, LDS_MISC = LDS_BYTES - 1024;

__device__ __forceinline__ unsigned f2bf(float f) { unsigned u = __builtin_bit_cast(unsigned, f); return (u + 0x7fffu + ((u >> 16) & 1u)) >> 16; }
__device__ __forceinline__ float bf2f(unsigned b) { return __builtin_bit_cast(float, b << 16); }
__device__ __forceinline__ unsigned cvt_pk_bf16(float lo, float hi) { unsigned r; asm volatile("v_cvt_pk_bf16_f32 %0, %1, %2" : "=v"(r) : "v"(lo), "v"(hi)); return r; }
template <int M> __device__ __forceinline__ float shx(float v, int lane) {
    if constexpr (M < 32) return __builtin_bit_cast(float, __builtin_amdgcn_ds_swizzle(__builtin_bit_cast(int, v), (M << 10) | 0x1f));
    else return __builtin_bit_cast(float, __builtin_amdgcn_ds_bpermute((lane ^ 32) << 2, __builtin_bit_cast(int, v)));
}
__device__ __forceinline__ float wave_sum(float v, int lane) {
    v += shx<1>(v, lane); v += shx<2>(v, lane); v += shx<4>(v, lane); v += shx<8>(v, lane); v += shx<16>(v, lane); v += shx<32>(v, lane);
    return v;
}
__device__ __forceinline__ float gelu_tanh(float x) { const float w = x * __builtin_fmaf(x * x, -0.044715f * 1.5957691216f * 1.4426950408889634f, -1.5957691216f * 1.4426950408889634f); return x * __builtin_amdgcn_rcpf(1.0f + __builtin_amdgcn_exp2f(w)); }
__device__ __forceinline__ float sigmoidf_(float x) { return __builtin_amdgcn_rcpf(1.0f + __expf(-x)); }
#define LDS_WAIT() asm volatile("s_waitcnt lgkmcnt(0)" ::: "memory")
template <class T> __device__ __forceinline__ T* opq(T* p) { asm volatile("" : "+s"(p)); return p; }
__device__ __forceinline__ int opq_v(int v) { asm volatile("" : "+v"(v)); return v; }
__device__ __forceinline__ unsigned opq_u(unsigned v) { asm volatile("" : "+v"(v)); return v; }
__device__ __forceinline__ LAS unsigned char* opq_l(LAS unsigned char* p) { unsigned v = (unsigned)(size_t)p; asm volatile("" : "+s"(v)); return (LAS unsigned char*)(size_t)v; }

#define XB_TMO      128
#define XB_XCNT(j)  (256  + 64 * (j))
#define XB_XSUB(j)  (1280 + 64 * (j))
#define XB_XGEN(j)  (2304 + 64 * (j))
#define XB_TOP      3328
#define XB_TOPGEN   3392
#define XCD_BAR_WORDS 3456
#define XB_SPIN_CAP (1u << 18)
__device__ __forceinline__ unsigned xb_ld(unsigned* p)              { return __hip_atomic_load(p, __ATOMIC_RELAXED, __HIP_MEMORY_SCOPE_AGENT); }
__device__ __forceinline__ unsigned xb_add(unsigned* p, unsigned v) { return __hip_atomic_fetch_add(p, v, __ATOMIC_RELAXED, __HIP_MEMORY_SCOPE_AGENT); }
__device__ __forceinline__ unsigned xb_xcc_id() { return (unsigned)__builtin_amdgcn_s_getreg((3 << 11) | 20) & 0xFu; }
#define XB_SPIN(cond, bar) do { unsigned _sp = 0; while (cond) { __builtin_amdgcn_s_sleep(1); \
    if ((++_sp & 255u) == 0u) { if (xb_ld(&(bar)[XB_TMO])) break; if (_sp > XB_SPIN_CAP) { atomicAdd(&(bar)[XB_TMO], 1u); break; } } } } while (0)
struct XcdBarrier { unsigned* bar; unsigned x; volatile LAS unsigned* st; };
__device__ __forceinline__ XcdBarrier xcd_barrier_post(unsigned* bar, volatile LAS unsigned* st) {
    XcdBarrier b; b.bar = bar; b.x = xb_xcc_id(); b.st = st;
    if (threadIdx.x == 0) (void)xb_add(&bar[XB_XCNT(b.x)], 1u);
    return b;
}
__device__ __forceinline__ void xcd_barrier_complete(unsigned* bar, unsigned x, unsigned& nloc, unsigned& nx) {
    const unsigned G = gridDim.x * gridDim.y * gridDim.z;
    unsigned sum, cnt, mine, sp = 0u;
    for (;;) {
        sum = 0u; cnt = 0u; mine = 0u;
#pragma unroll
        for (unsigned j = 0; j < 16; ++j) { const unsigned c = xb_ld(&bar[XB_XCNT(j)]); sum += c; cnt += (c > 0u) ? 1u : 0u; mine = (j == x) ? c : mine; }
        if (sum == G) break;
        __builtin_amdgcn_s_sleep(1);
        if ((++sp & 255u) == 0u) { if (xb_ld(&bar[XB_TMO])) break; if (sp > XB_SPIN_CAP) { atomicAdd(&bar[XB_TMO], 1u); break; } }
    }
    nloc = mine > 0u ? mine : 1u; nx = cnt > 0u ? cnt : 1u;
}
__device__ __forceinline__ void xcd_barrier(const XcdBarrier& b) {
    asm volatile("s_waitcnt vmcnt(0)" ::: "memory");
    __syncthreads();
    if (threadIdx.x == 0) {
        unsigned* bar = b.bar;
        __builtin_amdgcn_s_waitcnt(0);
        unsigned nloc = b.st[0], nx = b.st[1];
        if (nloc == 0u) { xcd_barrier_complete(bar, b.x, nloc, nx); b.st[0] = nloc; b.st[1] = nx; }
        const unsigned old = xb_add(&bar[XB_XSUB(b.x)], 1u);
        const unsigned gen = old / nloc;
        if (old + 1u == (gen + 1u) * nloc) {
            __builtin_amdgcn_fence(__ATOMIC_RELEASE, "agent");
            asm volatile("s_waitcnt vmcnt(0)" ::: "memory");
            const unsigned og = xb_add(&bar[XB_TOP], 1u);
            const unsigned tg = og / nx;
            if (og + 1u == (tg + 1u) * nx) xb_add(&bar[XB_TOPGEN], 1u);
            else XB_SPIN(xb_ld(&bar[XB_TOPGEN]) == tg, bar);
            __builtin_amdgcn_fence(__ATOMIC_ACQUIRE, "agent");
            xb_add(&bar[XB_XGEN(b.x)], 1u);
            asm volatile("s_waitcnt vmcnt(0)" ::: "memory");
        } else {
            XB_SPIN(xb_ld(&bar[XB_XGEN(b.x)]) == gen, bar);
            __builtin_amdgcn_fence(__ATOMIC_ACQUIRE, "agent");
            asm volatile("s_waitcnt vmcnt(0)" ::: "memory");
        }
    }
    __syncthreads();
}

namespace g8 {
constexpr int BM = 256, BK = 64, HALF = 128, HTB = HALF * BK * 2, NXCD = 8, WGM = 8;
__device__ __forceinline__ int lds_byte(int r, int c) { const int st = (r >> 4) * 2 + (c >> 5), rr = r & 15, cc = c & 31, ob = rr * 64 + cc * 2; return st * 1024 + (ob ^ (((ob >> 9) & 1) << 5)); }
__device__ __forceinline__ void stage_rc(int b, int& R, int& C) { const int st = b / 1024, sb = b % 1024, swz = sb ^ (((sb >> 9) & 1) << 5); R = (st >> 1) * 16 + swz / 64; C = (st & 1) * 32 + (swz % 64) / 2; }
__device__ __forceinline__ int perm32(int rho) { const int n = rho >> 4, i = rho & 15; return 8 * (i >> 2) + 4 * n + (i & 3); }

struct GUnit { int pm, pn; unsigned a, b; int x, y, kt; };

struct SchedDense {
    static constexpr bool GATHER = false, VARK = false;
    const char* A; const char* B; unsigned tsA, tsB; int nM, nN, nwg, G, c;
    __device__ __forceinline__ void init(const void* A_, const void* B_, int M, int N, int lda, int ldb, int G_, int c_) {
        A = (const char*)A_; B = (const char*)B_; nM = M / BM; nN = N / BM; nwg = nM * nN; G = G_; c = c_; tsA = (unsigned)(BM * lda * 2); tsB = (unsigned)(BM * ldb * 2); }
    __device__ __forceinline__ bool next(int i, GUnit& u) const {
        const long L = (long)i * G + c; if (L >= nwg) return false;
        int wgid = (int)L; { const int q = nwg / NXCD, r = nwg % NXCD, xcd = wgid % NXCD, off = wgid / NXCD; wgid = (xcd < r ? xcd * (q + 1) : r * (q + 1) + (xcd - r) * q) + off; }
        const int nig = WGM * nN, gid = wgid / nig, fm = gid * WGM, gsz = (nM - fm) < WGM ? (nM - fm) : WGM;
        u.pm = fm + ((wgid % nig) % gsz); u.pn = (wgid % nig) / gsz; u.a = (unsigned)u.pm * tsA; u.b = (unsigned)u.pn * tsB; u.x = 0; u.y = 0; return true;
    }
    __device__ __forceinline__ unsigned arow(const GUnit&, int) const { return 0u; }
};
struct SchedMerge {
    static constexpr bool GATHER = false, VARK = true;
    const char* A; const char* B; SchedDense D;
    __device__ __forceinline__ void init(const void* A_, const void* B_, int M, int G_, int c_) { A = (const char*)A_; B = (const char*)B_; D.init(A_, B_, M, 1024, KCAT, KCAT, G_, c_); }
    __device__ __forceinline__ bool next(int i, GUnit& u) const {
        const int tr = i / 3, j = i - 3 * tr; if (!D.next(tr, u)) return false;
        const unsigned ko = j == 0 ? 0u : (j == 1 ? 1024u : 1792u);
        u.a += ko; u.b += ko; u.x = j; u.kt = (j == 1) ? 6 : 8; return true;
    }
    __device__ __forceinline__ unsigned arow(const GUnit&, int) const { return 0u; }
};
struct SchedS5 {
    static constexpr bool GATHER = false, VARK = false;
    const char* A; const char* B; unsigned bstride; int G, c;
    __device__ __forceinline__ bool next(int i, GUnit& u) const {
        const int L = i * G + c; if (L >= 24 * 9) return false;
        const int g = L / 9, tl = L % 9; u.pm = tl; u.pn = 0; u.x = g; u.y = 0;
        u.a = (unsigned)((g * S5R + 256 * tl) * 512) * 2u; u.b = (unsigned)g * bstride; return true;
    }
    __device__ __forceinline__ unsigned arow(const GUnit&, int) const { return 0u; }
};
struct SchedMoeUp {
    static constexpr bool GATHER = true, VARK = false;
    const char* A; const char* B; const int* ltok; const LAS int* tstart; const LAS int* cnt; int G, c;
    __device__ __forceinline__ bool next(int i, GUnit& u) const {
        const int L = i * G + c; const int T = L >> 1; if (T >= tstart[64]) return false;
        int q = 0;
#pragma unroll
        for (int st = 32; st >= 1; st >>= 1) q += (tstart[q + st] <= T) ? st : 0;
        u.pm = T; u.pn = L & 1; u.x = q; u.y = T - tstart[q]; u.a = 0u; u.b = (unsigned)(((q & 31) * 512 + (L & 1) * 256) * 1024) * 2u; return true;
    }
    __device__ __forceinline__ unsigned arow(const GUnit& u, int R) const {
        const int idx = 256 * u.y + R; const int tok = idx < cnt[u.x] ? ltok[(size_t)u.x * LCAP + idx] : 0; return (unsigned)tok * 2048u; }
};
struct SchedMoeDown {
    static constexpr bool GATHER = false, VARK = false;
    const char* A; const char* B; const LAS int* tstart; int G, c;
    __device__ __forceinline__ bool next(int i, GUnit& u) const {
        const int L = i * G + c; const int T = L >> 2; if (T >= tstart[64]) return false;
        int q = 0;
#pragma unroll
        for (int st = 32; st >= 1; st >>= 1) q += (tstart[q + st] <= T) ? st : 0;
        u.pm = T; u.pn = L & 3; u.x = q; u.y = T - tstart[q]; u.a = (unsigned)(T * 256 * 256) * 2u; u.b = (unsigned)(((q & 31) * 1024 + (L & 3) * 256) * 256) * 2u; return true;
    }
    __device__ __forceinline__ unsigned arow(const GUnit&, int) const { return 0u; }
};

template <class Epi, class Sched>
__device__ __forceinline__ void gemm_run(LAS unsigned char* lds, const int K, const int lda, const int ldb, const Sched& S, const Epi& E) {
    const int tid = opq_v((int)threadIdx.x), wid = __builtin_amdgcn_readfirstlane(tid >> 6), lane = tid & 63, wr = wid >> 2, wc = wid & 3, fr = lane & 15, fq = lane >> 4;
    const int nt = K / BK;
    constexpr int NH = Sched::GATHER ? 2 : 1;
    unsigned voffB[2], vAc[NH][2];
#pragma unroll
    for (int i = 0; i < 2; ++i) { int R, C; stage_rc(tid * 16 + i * 8192, R, C); const int Rb = Epi::PERM ? ((R & ~31) + perm32(R & 31)) : R;
        voffB[i] = (unsigned)(Rb * ldb + C) * 2u; }
    constexpr unsigned kstep = BK * 2;
    const unsigned hstepB = (unsigned)(HALF * ldb * 2);
    const unsigned hstepA = Sched::GATHER ? 0u : (unsigned)(HALF * lda * 2);
    const char* const baseA = S.A; const char* const baseB = S.B;
    const unsigned ldsw = (unsigned)wid * 1024u;
    const int aoff = lds_byte(wr * 64 + fr, fq * 8), boff = lds_byte(wc * 32 + fr, fq * 8);
#define G8_SA(b, h) (((b) * 2 + (h)) * HTB)
#define G8_SB(b, h) ((4 + (b) * 2 + (h)) * HTB)
#define G8_STAGE_A(bufoff, gbase, VA, h) do { _Pragma("unroll") for (int _i = 0; _i < 2; ++_i) \
        __builtin_amdgcn_global_load_lds((const unsigned*)(baseA + ((gbase) + (h) * hstepA) + opq_u((VA)[(h) * (NH - 1)][_i])), (LAS unsigned*)(lds + (bufoff) + ldsw + _i * 8192), 16, 0, 0); } while (0)
#define G8_STAGE_B(bufoff, gbase) do { _Pragma("unroll") for (int _i = 0; _i < 2; ++_i) \
        __builtin_amdgcn_global_load_lds((const unsigned*)(baseB + (gbase) + opq_u(voffB[_i])), (LAS unsigned*)(lds + (bufoff) + ldsw + _i * 8192), 16, 0, 0); } while (0)
#define G8_LDA(dst, b, h) do { _Pragma("unroll") for (int m = 0; m < 4; ++m) _Pragma("unroll") for (int k = 0; k < 2; ++k) dst[m][k] = *(const LAS bf16x8*)(lds + G8_SA(b, h) + aoff + m * 2048 + k * 1024); } while (0)
#define G8_LDB(dst, b, h) do { _Pragma("unroll") for (int n = 0; n < 2; ++n) _Pragma("unroll") for (int k = 0; k < 2; ++k) dst[n][k] = *(const LAS bf16x8*)(lds + G8_SB(b, h) + boff + n * 2048 + k * 1024); } while (0)
#define G8_MMA(ai, bj, At, Bt) do { __builtin_amdgcn_s_setprio(1); _Pragma("unroll") for (int m = 0; m < 4; ++m) _Pragma("unroll") for (int n = 0; n < 2; ++n) _Pragma("unroll") for (int k = 0; k < 2; ++k) \
        acc[ai][bj][m][n] = __builtin_amdgcn_mfma_f32_16x16x32_bf16(Bt[n][k], At[m][k], acc[ai][bj][m][n], 0, 0, 0); __builtin_amdgcn_s_setprio(0); } while (0)
#define G8_WAIT_V(n) asm volatile("s_waitcnt vmcnt(" #n ")" ::: "memory")
#define G8_WAIT_L(n) asm volatile("s_waitcnt lgkmcnt(" #n ")" ::: "memory")
#define G8_BAR __builtin_amdgcn_s_barrier()
#define G8_SCHED __builtin_amdgcn_sched_barrier(0)
#define G8_KPAIR_A(a1) do { \
            G8_LDB(B0, 0, 0); G8_LDB(B1, 0, 1); G8_SCHED; G8_LDA(At, 0, 0); G8_STAGE_A(G8_SA(1, 1), (a1), vAc, 1); \
            G8_WAIT_V(8); G8_WAIT_L(0); G8_BAR; G8_MMA(0, 0, At, B0); G8_MMA(0, 1, At, B1); G8_BAR; G8_SCHED; } while (0)
#define G8_KPAIR_B(a2, b2, VA2) do { \
            G8_LDA(At, 0, 1); G8_STAGE_B(G8_SB(0, 0), (b2)); G8_STAGE_B(G8_SB(0, 1), (b2) + hstepB); G8_STAGE_A(G8_SA(0, 0), (a2), VA2, 0); \
            G8_WAIT_V(8); G8_WAIT_L(0); G8_BAR; G8_MMA(1, 0, At, B0); G8_MMA(1, 1, At, B1); G8_BAR; G8_SCHED; \
            G8_LDB(B0, 1, 0); G8_LDB(B1, 1, 1); G8_SCHED; G8_LDA(At, 1, 0); G8_STAGE_A(G8_SA(0, 1), (a2), VA2, 1); \
            G8_WAIT_V(8); G8_WAIT_L(0); G8_BAR; G8_MMA(0, 0, At, B0); G8_MMA(0, 1, At, B1); G8_BAR; G8_SCHED; \
            G8_LDA(At, 1, 1); G8_STAGE_B(G8_SB(1, 0), (b2) + kstep); G8_STAGE_B(G8_SB(1, 1), (b2) + kstep + hstepB); G8_STAGE_A(G8_SA(1, 0), (a2) + kstep, VA2, 0); \
            G8_WAIT_V(8); G8_WAIT_L(0); G8_BAR; G8_MMA(1, 0, At, B0); G8_MMA(1, 1, At, B1); G8_BAR; G8_SCHED; } while (0)
#define G8_KPAIR(a1, a2, b2, VA2) do { G8_KPAIR_A(a1); G8_KPAIR_B(a2, b2, VA2); } while (0)
    GUnit cur, nxt; int ui = 0;
    if (!S.next(0, cur)) return;
    f32x4 acc[2][2][4][2];
#pragma unroll
    for (int a = 0; a < 2; ++a)
#pragma unroll
        for (int b = 0; b < 2; ++b)
#pragma unroll
            for (int m = 0; m < 4; ++m)
#pragma unroll
                for (int n = 0; n < 2; ++n) acc[a][b][m][n] = (f32x4){0.f, 0.f, 0.f, 0.f};
    bf16x8 At[4][2], B0[2][2], B1[2][2];
#pragma unroll
    for (int h = 0; h < NH; ++h)
#pragma unroll
        for (int i = 0; i < 2; ++i) { int R, C; stage_rc(tid * 16 + i * 8192, R, C);
            if constexpr (Sched::GATHER) vAc[h][i] = S.arow(cur, R + HALF * h) + (unsigned)C * 2u;
            else vAc[h][i] = (unsigned)(R * lda + C) * 2u; }
    unsigned cA = cur.a, cB = cur.b;
    G8_STAGE_B(G8_SB(0, 0), cB); G8_STAGE_B(G8_SB(0, 1), cB + hstepB); G8_STAGE_A(G8_SA(0, 0), cA, vAc, 0); G8_STAGE_A(G8_SA(0, 1), cA, vAc, 1);
    if (wr == 1) G8_BAR;
    G8_WAIT_V(2); G8_BAR;
    G8_STAGE_B(G8_SB(1, 0), cB + kstep); G8_STAGE_A(G8_SA(1, 0), cA + kstep, vAc, 0); G8_STAGE_B(G8_SB(1, 1), cB + kstep + hstepB);
    G8_WAIT_V(6); G8_BAR;
    for (;;) {
        const bool has_next = S.next(ui + 1, nxt);
        const unsigned nA = has_next ? nxt.a : cA, nB = has_next ? nxt.b : cB;
        const int ntu = Sched::VARK ? cur.kt : nt;
        for (int t = 0; t < ntu - 2; t += 2) { const unsigned a1 = cA + (unsigned)(t + 1) * kstep, a2 = cA + (unsigned)(t + 2) * kstep, b2 = cB + (unsigned)(t + 2) * kstep; G8_KPAIR(a1, a2, b2, vAc); }
        {
            const unsigned a1 = cA + (unsigned)(ntu - 1) * kstep;
            if constexpr (Sched::GATHER) {
                G8_KPAIR_A(a1);
                if (has_next) {
#pragma unroll
                    for (int h = 0; h < 2; ++h)
#pragma unroll
                        for (int i = 0; i < 2; ++i) { int R, C; stage_rc(tid * 16 + i * 8192, R, C); vAc[h][i] = S.arow(nxt, R + HALF * h) + (unsigned)C * 2u; }
                }
                G8_KPAIR_B(nA, nB, vAc);
            } else {
                G8_KPAIR(a1, nA, nB, vAc);
            }
        }
        if (wr == 0) G8_BAR;
        E(acc, cur, wr, wc, opq_v(fr), opq_v(fq));
        if (!has_next) break;
        if (E.zero_after(cur)) {
#pragma unroll
        for (int a = 0; a < 2; ++a)
#pragma unroll
            for (int b = 0; b < 2; ++b)
#pragma unroll
                for (int m = 0; m < 4; ++m)
#pragma unroll
                    for (int n = 0; n < 2; ++n) acc[a][b][m][n] = (f32x4){0.f, 0.f, 0.f, 0.f};
        }
        cur = nxt; cA = nA; cB = nB; ++ui;
        if (wr == 1) G8_BAR;
    }
    G8_WAIT_V(0);
    G8_BAR;
#undef G8_SA
#undef G8_SB
#undef G8_STAGE_A
#undef G8_STAGE_B
#undef G8_LDA
#undef G8_LDB
#undef G8_MMA
#undef G8_WAIT_V
#undef G8_WAIT_L
#undef G8_BAR
#undef G8_SCHED
#undef G8_KPAIR
#undef G8_KPAIR_A
#undef G8_KPAIR_B
}

typedef f32x4 Acc[2][2][4][2];

__device__ __forceinline__ u32x4 pack8(const f32x4 v0, const f32x4 v1) { u32x4 w; w.x = cvt_pk_bf16(v0[0], v0[1]); w.y = cvt_pk_bf16(v0[2], v0[3]); w.z = cvt_pk_bf16(v1[0], v1[1]); w.w = cvt_pk_bf16(v1[2], v1[3]); return w; }

struct EpiWin {
    static constexpr bool PERM = true; __device__ __forceinline__ bool zero_after(const GUnit&) const { return true; }
    unsigned char* wsb; LAS unsigned char* tsc;
    __device__ __forceinline__ void operator()(Acc& acc, const GUnit& u, int wr, int wc, int fr, int fq) const {
        bf16_t* const uvg = (bf16_t*)(wsb + WS_UVG); bf16_t* const qk = (bf16_t*)(wsb + WS_QK); bf16_t* const vt = (bf16_t*)(wsb + WS_VT); bf16_t* const vtc = (bf16_t*)(wsb + WS_VT + 32 * MiB);
        unsigned char* const gates = wsb + WS_G; bf16_t* const s5a = (bf16_t*)(wsb + WS_S5A); const float* const ropec = (const float*)(wsb + WS_ROPE); const float* const ropes = ropec + 128 * 16;
        const int pn = u.pn, row0 = u.pm * 256 + wr * 64 + fr, cl = wc * 32 + 8 * fq;
        if (pn < 4) {
#pragma unroll
            for (int ai = 0; ai < 2; ++ai)
#pragma unroll
                for (int m = 0; m < 4; ++m) { bf16_t* rp = uvg + (size_t)(row0 + ai * 128 + m * 16) * 1024 + pn * 256 + cl;
#pragma unroll
                    for (int bj = 0; bj < 2; ++bj) { f32x4 v0 = acc[ai][bj][m][0], v1 = acc[ai][bj][m][1];
#pragma unroll
                        for (int j = 0; j < 4; ++j) { v0[j] = gelu_tanh(v0[j]); v1[j] = gelu_tanh(v1[j]); }
                        *(u32x4*)(rp + bj * 128) = pack8(v0, v1); } }
        } else if (pn < 8) {
            const float sc = pn < 6 ? 0.125f * 1.4426950408889634f : 1.0f;   const bool lat = u.pm < 128; const int seg = wc & 1, f0 = 8 * (fq & 1); const float sg = fq < 2 ? -1.f : 1.f;
#pragma unroll
            for (int ai = 0; ai < 2; ++ai) { const int grow = (4 * u.pm + 2 * ai + wr) & 127;
#pragma unroll
                for (int m = 0; m < 4; ++m) { bf16_t* rp = qk + (size_t)(row0 + ai * 128 + m * 16) * 1024 + (pn - 4) * 256 + cl;
                    const int pos = seg ? (16 * m + fr) : grow;
                    f32x4 c0 = {1.f, 1.f, 1.f, 1.f}, c1 = c0, s0 = {0.f, 0.f, 0.f, 0.f}, s1 = s0;
                    if (lat) { c0 = *(const f32x4*)(ropec + pos * 16 + f0); c1 = *(const f32x4*)(ropec + pos * 16 + f0 + 4); s0 = *(const f32x4*)(ropes + pos * 16 + f0); s1 = *(const f32x4*)(ropes + pos * 16 + f0 + 4); }
#pragma unroll
                    for (int bj = 0; bj < 2; ++bj) { f32x4 v0 = acc[ai][bj][m][0], v1 = acc[ai][bj][m][1], o0, o1;
#pragma unroll
                        for (int j = 0; j < 4; ++j) { const float x0 = shx<32>(v0[j], fr + 16 * fq), x1 = shx<32>(v1[j], fr + 16 * fq);
                            o0[j] = (v0[j] * c0[j] + sg * x0 * s0[j]) * sc; o1[j] = (v1[j] * c1[j] + sg * x1 * s1[j]) * sc; }
                        *(u32x4*)(rp + bj * 128) = pack8(o0, o1); } } }
        } else if (pn < 10) {
            LAS bf16_t* tb = (LAS bf16_t*)(tsc + (wr * 4 + wc) * 2048); const int lane_ = fr + 16 * fq, tcol = lane_ >> 1, thalf = lane_ & 1;
            int it_ = 0;
#pragma unroll
            for (int ai = 0; ai < 2; ++ai)
#pragma unroll
                for (int m = 0; m < 4; ++m) { const int rowb = u.pm * 256 + wr * 64 + ai * 128 + m * 16;
                    bf16_t* bp; size_t stride;
                    if (rowb < NLAT) { bp = vt + (size_t)((rowb >> 13) * 512) * 8192 + (rowb & 8191); stride = 8192; }
                    else { const int rr = rowb - NLAT; bp = vtc + (size_t)((rr >> 8) * 512) * 256 + (rr & 255); stride = 256; }
#pragma unroll
                    for (int bj = 0; bj < 2; ++bj, ++it_) { LAS bf16_t* t = tb + (it_ & 1) * 512;
#pragma unroll
                        for (int n = 0; n < 2; ++n)
#pragma unroll
                            for (int j = 0; j < 4; ++j) t[(8 * fq + 4 * n + j) * 16 + fr] = (bf16_t)f2bf(acc[ai][bj][m][n][j]);
                        asm volatile("s_waitcnt lgkmcnt(0)" ::: "memory");
                        const u32x4 v = *(const LAS u32x4*)(t + tcol * 16 + thalf * 8);
                        const int c = (pn - 8) * 256 + bj * 128 + wc * 32 + tcol;
                        *(u32x4*)(bp + (size_t)c * stride + thalf * 8) = v; } }
        } else if (pn < 22) {
#pragma unroll
            for (int ai = 0; ai < 2; ++ai)
#pragma unroll
                for (int m = 0; m < 4; ++m) { unsigned char* rp = gates + (size_t)(row0 + ai * 128 + m * 16) * 3072 + (pn - 10) * 256 + cl;
#pragma unroll
                    for (int bj = 0; bj < 2; ++bj) { u32x2 w;
#pragma unroll
                        for (int n = 0; n < 2; ++n) { unsigned pk = 0;
#pragma unroll
                            for (int j = 0; j < 4; ++j) { const float e = __builtin_amdgcn_exp2f(acc[ai][bj][m][n][j] * -1.4426950408889634f);
                                const float q = fmaxf(__builtin_amdgcn_rcpf(__builtin_fmaf(e, 1.0f / 255.0f, 1.0f / 255.0f)), 1.0f); pk = __builtin_amdgcn_cvt_pk_u8_f32(q, j, pk); }
                            w[n] = pk; }
                        *(u32x2*)(rp + bj * 128) = w; } }
        } else {
#pragma unroll
            for (int bj = 0; bj < 2; ++bj) { const int ch = (pn - 22) * 256 + bj * 128 + cl;
                if (ch < 384) { const int g = ch >> 4, c0 = ch & 15;
#pragma unroll
                    for (int ai = 0; ai < 2; ++ai)
#pragma unroll
                        for (int m = 0; m < 4; ++m) { const int row = row0 + ai * 128 + m * 16;
                            *(u32x4*)(s5a + ((size_t)(g * S5R + (row >> 4)) * 512) + (row & 15) * 16 + c0) = pack8(acc[ai][bj][m][0], acc[ai][bj][m][1]); } } }
        }
    }
};

struct EpiMerge {
    static constexpr bool PERM = true;
    const unsigned char* gates; bf16_t* mb;
    __device__ __forceinline__ bool zero_after(const GUnit& u) const { return u.x == 2; }
    __device__ __forceinline__ void operator()(Acc& acc, const GUnit& u, int wr, int wc, int fr, int fq) const {
        const int row0 = u.pm * 256 + wr * 64 + fr, col = u.pn * 256 + wc * 32 + 8 * fq; const int j = u.x;
        if (j < 2) {
#pragma unroll
            for (int ai = 0; ai < 2; ++ai)
#pragma unroll
                for (int m = 0; m < 4; ++m) { const unsigned char* rp = gates + (size_t)(row0 + ai * 128 + m * 16) * 3072 + 1024 * j + col;
#pragma unroll
                    for (int bj = 0; bj < 2; ++bj) { const u32x2 ga = *(const u32x2*)(rp + bj * 128), gb = *(const u32x2*)(rp + bj * 128 + 1024);
#pragma unroll
                        for (int n = 0; n < 2; ++n)
#pragma unroll
                            for (int k = 0; k < 4; ++k) { const float a = (float)((ga[n] >> (8 * k)) & 255u), b = (float)((gb[n] >> (8 * k)) & 255u);
                                acc[ai][bj][m][n][k] *= a * __builtin_amdgcn_rcpf(b); } }
                    if (m == 3) asm volatile("" ::: "memory"); }
        } else {
#pragma unroll
            for (int ai = 0; ai < 2; ++ai)
#pragma unroll
                for (int m = 0; m < 4; ++m) { const size_t row = (size_t)(row0 + ai * 128 + m * 16); const unsigned char* rp = gates + row * 3072 + 2048 + col;
#pragma unroll
                    for (int bj = 0; bj < 2; ++bj) { const u32x2 gc = *(const u32x2*)(rp + bj * 128); f32x4 v0, v1;
#pragma unroll
                        for (int k = 0; k < 4; ++k) { v0[k] = acc[ai][bj][m][0][k] * ((float)((gc[0] >> (8 * k)) & 255u) * (1.0f / 255.0f)); v1[k] = acc[ai][bj][m][1][k] * ((float)((gc[1] >> (8 * k)) & 255u) * (1.0f / 255.0f)); }
                        *(u32x4*)(mb + row * 1024 + col + bj * 128) = pack8(v0, v1); }
                    if (m & 1) asm volatile("" ::: "memory"); }
        }
    }
};

struct EpiWout {
    static constexpr bool PERM = false; __device__ __forceinline__ bool zero_after(const GUnit&) const { return true; }
    const float* old_lat; const float* old_ctx; float* new_lat; float* new_ctx; const float* modl; float sc;
    __device__ __forceinline__ void operator()(Acc& acc, const GUnit& u, int wr, int wc, int fr, int fq) const {
        const bool lat = u.pm < 128; const int mrow = lat ? (u.pm >> 5) : 4;
        const float* gp = modl + mrow * 6144 + 2048; const int col0 = u.pn * 256 + wc * 32 + 4 * fq;
        const int rbase = (lat ? u.pm * 256 : (u.pm - 128) * 256) + wr * 64 + fr;
        const float* op = lat ? old_lat : old_ctx; float* np = lat ? new_lat : new_ctx;
        f32x4 gv[2][2];
#pragma unroll
        for (int bj = 0; bj < 2; ++bj)
#pragma unroll
            for (int n = 0; n < 2; ++n) gv[bj][n] = *(const f32x4*)(gp + col0 + bj * 128 + n * 16) * sc;
#pragma unroll
        for (int ai = 0; ai < 2; ++ai) { f32x4 xo[4][2][2];
#pragma unroll
            for (int m = 0; m < 4; ++m) { const size_t off = (size_t)(rbase + ai * 128 + m * 16) * 1024 + col0;
#pragma unroll
                for (int bj = 0; bj < 2; ++bj)
#pragma unroll
                    for (int n = 0; n < 2; ++n) xo[m][bj][n] = *(const f32x4*)(op + off + bj * 128 + n * 16); }
#pragma unroll
            for (int m = 0; m < 4; ++m) { const size_t off = (size_t)(rbase + ai * 128 + m * 16) * 1024 + col0;
#pragma unroll
                for (int bj = 0; bj < 2; ++bj)
#pragma unroll
                    for (int n = 0; n < 2; ++n) *(f32x4*)(np + off + bj * 128 + n * 16) = xo[m][bj][n] + gv[bj][n] * acc[ai][bj][m][n]; }
            asm volatile("" ::: "memory"); }
    }
};

struct EpiLogits {
    static constexpr bool PERM = false; __device__ __forceinline__ bool zero_after(const GUnit&) const { return true; }
    float* lg;
    __device__ __forceinline__ void operator()(Acc& acc, const GUnit& u, int wr, int wc, int fr, int fq) const {
        const int row0 = u.pm * 256 + wr * 64 + fr, col0 = wc * 32 + 4 * fq;
#pragma unroll
        for (int ai = 0; ai < 2; ++ai)
#pragma unroll
            for (int m = 0; m < 4; ++m) { float* rp = lg + (size_t)(row0 + ai * 128 + m * 16) * 128 + col0;
#pragma unroll
                for (int n = 0; n < 2; ++n) *(f32x4*)(rp + n * 16) = acc[ai][0][m][n]; }
    }
};

struct EpiS5E {
    static constexpr bool PERM = true; __device__ __forceinline__ bool zero_after(const GUnit&) const { return true; }
    bf16_t* e;
    __device__ __forceinline__ void operator()(Acc& acc, const GUnit& u, int wr, int wc, int fr, int fq) const {
        const int R0 = u.pm * 256 + wr * 64 + fr, cl = wc * 32 + 8 * fq;
#pragma unroll
        for (int ai = 0; ai < 2; ++ai)
#pragma unroll
            for (int m = 0; m < 4; ++m) { bf16_t* rp = e + ((size_t)(u.x * S5R + R0 + ai * 128 + m * 16) * 256) + cl;
#pragma unroll
                for (int bj = 0; bj < 2; ++bj) *(u32x4*)(rp + bj * 128) = pack8(acc[ai][bj][m][0], acc[ai][bj][m][1]); }
    }
};

struct EpiS5Y {
    static constexpr bool PERM = true; __device__ __forceinline__ bool zero_after(const GUnit&) const { return true; }
    bf16_t* yg;
    __device__ __forceinline__ void operator()(Acc& acc, const GUnit& u, int wr, int wc, int fr, int fq) const {
        const int R0 = u.pm * 256 + wr * 64 + fr, cl = wc * 32 + 8 * fq;
#pragma unroll
        for (int ai = 0; ai < 2; ++ai)
#pragma unroll
            for (int m = 0; m < 4; ++m) { const int R = R0 + ai * 128 + m * 16;
                if (R < S5RV) {
#pragma unroll
                    for (int bj = 0; bj < 2; ++bj) { const int col8 = bj * 128 + cl, i = col8 >> 4, co0 = col8 & 15; f32x4 v0 = acc[ai][bj][m][0], v1 = acc[ai][bj][m][1];
#pragma unroll
                        for (int j = 0; j < 4; ++j) { v0[j] = gelu_tanh(v0[j]); v1[j] = gelu_tanh(v1[j]); }
                        *(u32x4*)(yg + (size_t)(16 * R + i) * 384 + 16 * u.x + co0) = pack8(v0, v1); } } }
    }
};

struct EpiGlu {
    static constexpr bool PERM = true; __device__ __forceinline__ bool zero_after(const GUnit&) const { return true; }
    const bf16_t* yg; bf16_t* ycat;
    __device__ __forceinline__ void operator()(Acc& acc, const GUnit& u, int wr, int wc, int fr, int fq) const {
        const int row0 = u.pm * 256 + wr * 64 + fr, col0 = u.pn * 256 + wc * 32 + 8 * fq;
#pragma unroll
        for (int ai = 0; ai < 2; ++ai)
#pragma unroll
            for (int m = 0; m < 4; ++m) { const size_t row = (size_t)(row0 + ai * 128 + m * 16);
#pragma unroll
                for (int bj = 0; bj < 2; ++bj) {
                    if (u.pn == 0 || bj == 0) { const int col = col0 + bj * 128;
                        const u32x4 y = *(const u32x4*)(yg + row * 384 + col); f32x4 v0, v1;
#pragma unroll
                        for (int j = 0; j < 2; ++j) { v0[2 * j] = bf2f(y[j] & 0xffffu) * sigmoidf_(acc[ai][bj][m][0][2 * j]); v0[2 * j + 1] = bf2f(y[j] >> 16) * sigmoidf_(acc[ai][bj][m][0][2 * j + 1]);
                            v1[2 * j] = bf2f(y[2 + j] & 0xffffu) * sigmoidf_(acc[ai][bj][m][1][2 * j]); v1[2 * j + 1] = bf2f(y[2 + j] >> 16) * sigmoidf_(acc[ai][bj][m][1][2 * j + 1]); }
                        *(u32x4*)(ycat + row * KCAT + 512 + col) = pack8(v0, v1); } }
                asm volatile("" ::: "memory"); }
    }
};

struct EpiMoeUp {
    static constexpr bool PERM = true; __device__ __forceinline__ bool zero_after(const GUnit&) const { return true; }
    bf16_t* hid; const float* lw; const LAS int* cnt;
    __device__ __forceinline__ void operator()(Acc& acc, const GUnit& u, int wr, int wc, int fr, int fq) const {
        const int rit0 = wr * 64 + fr, cl = wc * 32 + 8 * fq; const int n_l = cnt[u.x];
#pragma unroll
        for (int ai = 0; ai < 2; ++ai)
#pragma unroll
            for (int m = 0; m < 4; ++m) { const int rit = rit0 + ai * 128 + m * 16, idx = 256 * u.y + rit;
                const float cw = idx < n_l ? lw[(size_t)u.x * LCAP + idx] : 0.f; f32x4 v0, v1;
#pragma unroll
                for (int j = 0; j < 4; ++j) { const float g0 = acc[ai][0][m][0][j], g1 = acc[ai][0][m][1][j];
                    v0[j] = g0 * sigmoidf_(g0) * acc[ai][1][m][0][j] * cw; v1[j] = g1 * sigmoidf_(g1) * acc[ai][1][m][1][j] * cw; }
                *(u32x4*)(hid + ((size_t)(256 * u.pm + rit) * 256) + 128 * u.pn + cl) = pack8(v0, v1); }
    }
};

struct EpiMoeDown {
    static constexpr bool PERM = true; __device__ __forceinline__ bool zero_after(const GUnit&) const { return true; }
    bf16_t* y0; bf16_t* y1; const int* ltok; const LAS int* cnt;
    __device__ __forceinline__ void operator()(Acc& acc, const GUnit& u, int wr, int wc, int fr, int fq) const {
        const int rit0 = wr * 64 + fr, col0 = u.pn * 256 + wc * 32 + 8 * fq; const int n_l = cnt[u.x]; bf16_t* y = u.x < 32 ? y0 : y1;
        int tk[2][4];
#pragma unroll
        for (int ai = 0; ai < 2; ++ai)
#pragma unroll
            for (int m = 0; m < 4; ++m) { const int idx = 256 * u.y + rit0 + ai * 128 + m * 16; tk[ai][m] = idx < n_l ? ltok[(size_t)u.x * LCAP + idx] : -1; }
#pragma unroll
        for (int ai = 0; ai < 2; ++ai)
#pragma unroll
            for (int m = 0; m < 4; ++m) { const int tok = tk[ai][m];
                if (tok >= 0) { bf16_t* yp = y + (size_t)tok * 1024 + col0;
#pragma unroll
                    for (int bj = 0; bj < 2; ++bj) *(u32x4*)(yp + bj * 128) = pack8(acc[ai][bj][m][0], acc[ai][bj][m][1]); } }
    }
};
}

struct Params { const float* in[34]; float* out; unsigned char* ws; };

__device__ __forceinline__ void tr_item(const float* src, int ldsrc, int ksrc0, int nsrc0, bf16_t* dst, int lddst, int ndst0, int kdst0, LAS float* scr, int lane) {
    { const int kr_ = lane >> 3, nq = (lane & 7) * 4; f32x4 t[8];
#pragma unroll
      for (int i = 0; i < 8; ++i) t[i] = src ? *(const f32x4*)(src + (size_t)(ksrc0 + 8 * i + kr_) * ldsrc + nsrc0 + nq) : (f32x4){0.f, 0.f, 0.f, 0.f};
#pragma unroll
      for (int i = 0; i < 8; ++i) { LAS float* d = scr + (8 * i + kr_) * 33 + nq; d[0] = t[i].x; d[1] = t[i].y; d[2] = t[i].z; d[3] = t[i].w; } }
    LDS_WAIT(); asm volatile("" ::: "memory");
    const int c = lane & 7;
#pragma unroll
    for (int j = 0; j < 4; ++j) { const int n = (lane >> 3) + 8 * j; const LAS float* s = scr + (8 * c) * 33 + n;
        u32x4 o; o.x = f2bf(s[0]) | (f2bf(s[33]) << 16); o.y = f2bf(s[66]) | (f2bf(s[99]) << 16); o.z = f2bf(s[132]) | (f2bf(s[165]) << 16); o.w = f2bf(s[198]) | (f2bf(s[231]) << 16);
        *(u32x4*)(dst + (size_t)(ndst0 + n) * lddst + kdst0 + 8 * c) = o; }
    LDS_WAIT(); asm volatile("" ::: "memory");
}

__device__ __forceinline__ void norm_mod_row(const float* xrow, const float* gain, const float* shift, const float* scale, bf16_t* orow, int lane, const bf16_t* yrow = nullptr, float* xwb = nullptr) {
    const f32x4* xr = (const f32x4*)xrow + lane; f32x4 v[4]; float s = 0.f;
#pragma unroll
    for (int j = 0; j < 4; ++j) { v[j] = xr[64 * j];
        if (yrow) { const u32x2 yy = *(const u32x2*)(yrow + 4 * lane + 256 * j); v[j].x += bf2f(yy.x & 0xffffu); v[j].y += bf2f(yy.x >> 16); v[j].z += bf2f(yy.y & 0xffffu); v[j].w += bf2f(yy.y >> 16); ((f32x4*)xwb + lane)[64 * j] = v[j]; }
        s += (v[j].x * v[j].x + v[j].y * v[j].y) + (v[j].z * v[j].z + v[j].w * v[j].w); }
    const float r = 1.0f / sqrtf(wave_sum(s, lane) * (1.0f / DM) + EPSN);
#pragma unroll
    for (int j = 0; j < 4; ++j) { const int c = 4 * lane + 256 * j; const f32x4 g = *(const f32x4*)(gain + c), sh = *(const f32x4*)(shift + c), sc = *(const f32x4*)(scale + c);
        const f32x4 h = (v[j] * r * g) * (sc + 1.0f) + sh;
        u32x2 o; o.x = cvt_pk_bf16(h.x, h.y); o.y = cvt_pk_bf16(h.z, h.w); *(u32x2*)(orow + c) = o; }
}

__device__ __forceinline__ void norm_mod_row2(const float* xa, const float* xb, const float* gain, const float* sha, const float* sca, const float* shb, const float* scb, bf16_t* oa, bf16_t* ob, int lane, const bf16_t* ya, const bf16_t* yb, const float* ga = nullptr, const float* gb = nullptr, const bf16_t* za = nullptr, const bf16_t* zb = nullptr) {
    const f32x4* pa = (const f32x4*)xa + lane; const f32x4* pb = (const f32x4*)xb + lane; f32x4 va[4], vb[4]; u32x2 qa[4], qb[4], ra_[4], rb_[4]; float s0 = 0.f, s1 = 0.f;
#pragma unroll
    for (int j = 0; j < 4; ++j) { va[j] = pa[64 * j]; vb[j] = pb[64 * j]; if (ya) { qa[j] = *(const u32x2*)(ya + 4 * lane + 256 * j); qb[j] = *(const u32x2*)(yb + 4 * lane + 256 * j); ra_[j] = *(const u32x2*)(za + 4 * lane + 256 * j); rb_[j] = *(const u32x2*)(zb + 4 * lane + 256 * j); } }
#pragma unroll
    for (int j = 0; j < 4; ++j) {
        if (ya) { const f32x4 g2a = *(const f32x4*)(ga + 4 * lane + 256 * j), g2b = *(const f32x4*)(gb + 4 * lane + 256 * j);
                  va[j].x += g2a.x * (bf2f(qa[j].x & 0xffffu) + bf2f(ra_[j].x & 0xffffu)); va[j].y += g2a.y * (bf2f(qa[j].x >> 16) + bf2f(ra_[j].x >> 16)); va[j].z += g2a.z * (bf2f(qa[j].y & 0xffffu) + bf2f(ra_[j].y & 0xffffu)); va[j].w += g2a.w * (bf2f(qa[j].y >> 16) + bf2f(ra_[j].y >> 16));
                  vb[j].x += g2b.x * (bf2f(qb[j].x & 0xffffu) + bf2f(rb_[j].x & 0xffffu)); vb[j].y += g2b.y * (bf2f(qb[j].x >> 16) + bf2f(rb_[j].x >> 16)); vb[j].z += g2b.z * (bf2f(qb[j].y & 0xffffu) + bf2f(rb_[j].y & 0xffffu)); vb[j].w += g2b.w * (bf2f(qb[j].y >> 16) + bf2f(rb_[j].y >> 16));
                  ((f32x4*)xa + lane)[64 * j] = va[j]; ((f32x4*)xb + lane)[64 * j] = vb[j]; }
        s0 += (va[j].x * va[j].x + va[j].y * va[j].y) + (va[j].z * va[j].z + va[j].w * va[j].w); s1 += (vb[j].x * vb[j].x + vb[j].y * vb[j].y) + (vb[j].z * vb[j].z + vb[j].w * vb[j].w); }
    const float ra = 1.0f / sqrtf(wave_sum(s0, lane) * (1.0f / DM) + EPSN), rb = 1.0f / sqrtf(wave_sum(s1, lane) * (1.0f / DM) + EPSN);
#pragma unroll
    for (int j = 0; j < 4; ++j) { const int c = 4 * lane + 256 * j; const f32x4 g = *(const f32x4*)(gain + c);
        { const f32x4 sh = *(const f32x4*)(sha + c), sc = *(const f32x4*)(sca + c); const f32x4 h = (va[j] * ra * g) * (sc + 1.0f) + sh; u32x2 o; o.x = cvt_pk_bf16(h.x, h.y); o.y = cvt_pk_bf16(h.z, h.w); *(u32x2*)(oa + c) = o; }
        { const f32x4 sh = *(const f32x4*)(shb + c), sc = *(const f32x4*)(scb + c); const f32x4 h = (vb[j] * rb * g) * (sc + 1.0f) + sh; u32x2 o; o.x = cvt_pk_bf16(h.x, h.y); o.y = cvt_pk_bf16(h.z, h.w); *(u32x2*)(ob + c) = o; } }
}

template <bool LATENT>
__device__ __forceinline__ void attn_tile(const bf16_t* qk, const bf16_t* vt, const bf16_t* vtc, bf16_t* ycat, const LAS float* rpbh, int b, int h, int qrow0, int r, int wt, int lane) {
    const int qi = lane & 15, g = lane >> 4;
    const bf16_t* qp = qk + (size_t)(qrow0 + qi) * 1024 + h * 64 + 8 * g;
    const bf16x8 qf0 = *(const bf16x8*)qp, qf1 = *(const bf16x8*)(qp + 32);
    float m_run = -1e30f, l_run = 0.f; f32x4 o[4];
#pragma unroll
    for (int d = 0; d < 4; ++d) o[d] = (f32x4){0.f, 0.f, 0.f, 0.f};
    const f32x4 z4 = {0.f, 0.f, 0.f, 0.f};
#define ATT_STEP(S0, S1, VB, VSTRIDE) do { \
        float cm = fmaxf(fmaxf(fmaxf(S0[0], S0[1]), fmaxf(S0[2], S0[3])), fmaxf(fmaxf(S1[0], S1[1]), fmaxf(S1[2], S1[3]))); \
        cm = fmaxf(cm, shx<16>(cm, lane)); cm = fmaxf(cm, shx<32>(cm, lane)); \
        const float mn = fmaxf(m_run, cm), al = __builtin_amdgcn_exp2f(m_run - mn); m_run = mn; \
        f32x4 p0, p1; float ps = 0.f; \
        _Pragma("unroll") for (int j = 0; j < 4; ++j) { p0[j] = __builtin_amdgcn_exp2f(S0[j] - mn); p1[j] = __builtin_amdgcn_exp2f(S1[j] - mn); ps += p0[j] + p1[j]; } \
        l_run = l_run * al + ps; \
        union { u32x4 u; bf16x8 v; } pb; pb.u = g8::pack8(p0, p1); \
        _Pragma("unroll") for (int db = 0; db < 4; ++db) { const bf16_t* vp = (VB) + (size_t)(16 * db + qi) * (VSTRIDE); \
            union { u32x4 u; bf16x8 v; } va; const u32x2 lo = *(const u32x2*)vp, hi = *(const u32x2*)(vp + 16); va.u.x = lo.x; va.u.y = lo.y; va.u.z = hi.x; va.u.w = hi.y; \
            o[db] = o[db] * al; o[db] = __builtin_amdgcn_mfma_f32_16x16x32_bf16(va.v, pb.v, o[db], 0, 0, 0); } } while (0)
    if (LATENT) {
        const int kr0 = min(max(r - 4, 0), 120); const int c0 = (wt == 0) ? 0 : (wt == 1 ? 8 : (wt == 2 ? 24 : 32));
        const int wq = 16 * wt + qi, cs = min(max(wq - 8, 0), 48);
#pragma unroll 2
        for (int jr = 0; jr < 8; ++jr) {
            const int kr = kr0 + jr, s0 = kr * 64 + c0;
            const bf16_t* kp = qk + (size_t)(b * 8192 + s0 + qi) * 1024 + 512 + h * 64 + 8 * g;
            const bf16x8 k00 = *(const bf16x8*)kp, k01 = *(const bf16x8*)(kp + 32), k10 = *(const bf16x8*)(kp + 16 * 1024), k11 = *(const bf16x8*)(kp + 16 * 1024 + 32);
            f32x4 sa = __builtin_amdgcn_mfma_f32_16x16x32_bf16(k00, qf0, z4, 0, 0, 0); sa = __builtin_amdgcn_mfma_f32_16x16x32_bf16(k01, qf1, sa, 0, 0, 0);
            f32x4 sb = __builtin_amdgcn_mfma_f32_16x16x32_bf16(k10, qf0, z4, 0, 0, 0); sb = __builtin_amdgcn_mfma_f32_16x16x32_bf16(k11, qf1, sb, 0, 0, 0);
            const LAS float* bp = rpbh + (kr - r + 7) * 31;
#pragma unroll
            for (int j = 0; j < 4; ++j) { const int wk = c0 + 4 * g + j; const int wk2 = wk + 16;
                const bool v0 = (wk >= cs) && (wk < cs + 16), v1 = (wk2 >= cs) && (wk2 < cs + 16);
                const int i0 = min(max(wk - wq + 15, 0), 30), i1 = min(max(wk2 - wq + 15, 0), 30);
                sa[j] = v0 ? sa[j] + bp[i0] : -1e30f; sb[j] = v1 ? sb[j] + bp[i1] : -1e30f; }
            const bf16_t* vb = vt + (size_t)((b * 8 + h) * 64) * 8192 + s0 + 4 * g;
            ATT_STEP(sa, sb, vb, 8192);
        }
    }
#pragma unroll 2
    for (int ch = 0; ch < 8; ++ch) {
        const int j0 = 32 * ch;
        const bf16_t* kp = qk + (size_t)(NLAT + b * 256 + j0 + qi) * 1024 + 512 + h * 64 + 8 * g;
        const bf16x8 k00 = *(const bf16x8*)kp, k01 = *(const bf16x8*)(kp + 32), k10 = *(const bf16x8*)(kp + 16 * 1024), k11 = *(const bf16x8*)(kp + 16 * 1024 + 32);
        f32x4 sa = __builtin_amdgcn_mfma_f32_16x16x32_bf16(k00, qf0, z4, 0, 0, 0); sa = __builtin_amdgcn_mfma_f32_16x16x32_bf16(k01, qf1, sa, 0, 0, 0);
        f32x4 sb = __builtin_amdgcn_mfma_f32_16x16x32_bf16(k10, qf0, z4, 0, 0, 0); sb = __builtin_amdgcn_mfma_f32_16x16x32_bf16(k11, qf1, sb, 0, 0, 0);
        const bf16_t* vb = vtc + (size_t)((b * 8 + h) * 64) * 256 + j0 + 4 * g;
        ATT_STEP(sa, sb, vb, 256);
    }
#undef ATT_STEP
    float l = l_run; l += shx<16>(l, lane); l += shx<32>(l, lane);
    const float inv = 1.0f / l;
    bf16_t* op = ycat + (size_t)(qrow0 + qi) * KCAT + 896 + h * 64 + 4 * g;
#pragma unroll
    for (int db = 0; db < 4; ++db) { u32x2 w; w.x = cvt_pk_bf16(o[db][0] * inv, o[db][1] * inv); w.y = cvt_pk_bf16(o[db][2] * inv, o[db][3] * inv); *(u32x2*)(op + 16 * db) = w; }
}

constexpr int ATT_RING = 16384, ATT_SB = 32768, ATT_NST = 15, ATT_NU = 512;
__device__ __forceinline__ void attn_lat_issue(LAS unsigned char* lds, const bf16_t* qk, const bf16_t* vt, const bf16_t* vtc, int T, int nT, int G, int bid, int wave, int lane) {
    const int Tc = T < nT ? T : nT - 1;
    const int ui = Tc / ATT_NST, s = Tc - ui * ATT_NST; const int u = bid + G * ui; const int hp = u & 3, r4 = (u >> 2) & 31, b = u >> 7;
    const int kr = min(min(max(4 * r4 - 4, 0), 120) + s, 127);
    LAS unsigned char* slot = lds + ATT_RING + (T & 3) * ATT_SB;
#pragma unroll
    for (int j = 0; j < 4; ++j) {
        const int c = (j * 8 + wave) * 64 + lane;
        const int cc = c & 1023, head = cc >> 9, row = (cc >> 3) & 63, lg = (cc & 7) ^ (row & 7), hh = 2 * hp + head;
        const bf16_t* gp;
        if (j < 2) { const int tok = (s < 11) ? (b * 8192 + kr * 64 + row) : (NLAT + b * 256 + 64 * (s - 11) + row); gp = qk + (size_t)tok * 1024 + 512 + hh * 64 + lg * 8; }
        else { gp = (s < 11) ? (vt + (size_t)((b * 8 + hh) * 64 + row) * 8192 + kr * 64 + lg * 8) : (vtc + (size_t)((b * 8 + hh) * 64 + row) * 256 + 64 * (s - 11) + lg * 8); }
        __builtin_amdgcn_global_load_lds((const unsigned*)gp, (LAS unsigned*)(slot + (j * 8 + wave) * 1024), 16, 0, 0);
    }
}
__device__ __forceinline__ void attn_lat_phase(LAS unsigned char* lds, const bf16_t* qk, const bf16_t* vt, const bf16_t* vtc, bf16_t* ycat, const LAS float* rpbS, int G, int bid, int wave, int lane) {
    const int nunits = (ATT_NU - bid + G - 1) / G; if (nunits <= 0) return;
    const int nT = nunits * ATT_NST;
    const int qi = lane & 15, g = lane >> 4, hl = wave >> 2, wt = wave & 3;
    const int c0 = (wt == 0) ? 0 : (wt == 1 ? 8 : (wt == 2 ? 24 : 32));
    const int wq = 16 * wt + qi, cs = min(max(wq - 8, 0), 48);
    float vm0[4], vm1[4];
#pragma unroll
    for (int j = 0; j < 4; ++j) { const int wk = c0 + 4 * g + j, wk2 = wk + 16; vm0[j] = ((wk >= cs) && (wk < cs + 16)) ? 0.f : -1e30f; vm1[j] = ((wk2 >= cs) && (wk2 < cs + 16)) ? 0.f : -1e30f; }
    const int boff = c0 + 4 * g - wq + 15;
    attn_lat_issue(lds, qk, vt, vtc, 0, nT, G, bid, wave, lane); attn_lat_issue(lds, qk, vt, vtc, 1, nT, G, bid, wave, lane); attn_lat_issue(lds, qk, vt, vtc, 2, nT, G, bid, wave, lane);
    int T = 0;
    const f32x4 z4 = {0.f, 0.f, 0.f, 0.f};
    for (int ui = 0; ui < nunits; ++ui) {
        const int u = bid + G * ui; const int hp = u & 3, r4 = (u >> 2) & 31, b = u >> 7; const int h = 2 * hp + hl;
        const int kstart = min(max(4 * r4 - 4, 0), 120); const int qrow = b * 8192 + (4 * r4) * 64 + 16 * wt + qi;
        bf16x8 qf[4][2]; float m_run[4], l_run[4]; f32x4 o[4][4];
#pragma unroll
        for (int i = 0; i < 4; ++i) { const bf16_t* qp = qk + (size_t)(qrow + 64 * i) * 1024 + h * 64 + 8 * g; qf[i][0] = *(const bf16x8*)qp; qf[i][1] = *(const bf16x8*)(qp + 32); m_run[i] = -1e30f; l_run[i] = 0.f;
#pragma unroll
            for (int d = 0; d < 4; ++d) o[i][d] = z4; }
        const LAS float* rpbh = rpbS + h * 465;
#pragma unroll 1
        for (int s = 0; s < ATT_NST; ++s, ++T) {
            asm volatile("s_waitcnt vmcnt(8)" ::: "memory");
            __builtin_amdgcn_s_barrier();
            asm volatile("" ::: "memory");
            attn_lat_issue(lds, qk, vt, vtc, T + 3, nT, G, bid, wave, lane);
            const LAS unsigned char* Kb = lds + ATT_RING + (T & 3) * ATT_SB + hl * 8192; const LAS unsigned char* Vb = Kb + 16384;
            const bool lat = s < 11; const int kr = kstart + s; const int nsub = lat ? 1 : 2;
            for (int ss = 0; ss < nsub; ++ss) {
                const int kb = lat ? c0 : 32 * ss;
                const int row0 = kb + qi, row1 = row0 + 16;
                const bf16x8 k00 = *(const LAS bf16x8*)(Kb + row0 * 128 + ((g ^ (row0 & 7)) << 4)), k01 = *(const LAS bf16x8*)(Kb + row0 * 128 + (((4 + g) ^ (row0 & 7)) << 4));
                const bf16x8 k10 = *(const LAS bf16x8*)(Kb + row1 * 128 + ((g ^ (row1 & 7)) << 4)), k11 = *(const LAS bf16x8*)(Kb + row1 * 128 + (((4 + g) ^ (row1 & 7)) << 4));
                bf16x8 vf[4];
                { const int off = (kb + 4 * g) * 2;
#pragma unroll
                  for (int db = 0; db < 4; ++db) { const int d = 16 * db + qi; const LAS unsigned char* vr = Vb + d * 128;
                      const u32x2 lo = *(const LAS u32x2*)(vr + ((((off >> 4) ^ (d & 7)) << 4) | (off & 15))), hi = *(const LAS u32x2*)(vr + (((((off + 32) >> 4) ^ (d & 7)) << 4) | (off & 15)));
                      union { u32x4 u; bf16x8 v; } va; va.u.x = lo.x; va.u.y = lo.y; va.u.z = hi.x; va.u.w = hi.y; vf[db] = va.v; } }
#pragma unroll
                for (int i = 0; i < 4; ++i) {
                    const int rq = 4 * r4 + i, kr0 = min(max(rq - 4, 0), 120);
                    if (!lat || (kr >= kr0 && kr <= kr0 + 7)) {
                        f32x4 sa = __builtin_amdgcn_mfma_f32_16x16x32_bf16(k00, qf[i][0], z4, 0, 0, 0); sa = __builtin_amdgcn_mfma_f32_16x16x32_bf16(k01, qf[i][1], sa, 0, 0, 0);
                        f32x4 sb = __builtin_amdgcn_mfma_f32_16x16x32_bf16(k10, qf[i][0], z4, 0, 0, 0); sb = __builtin_amdgcn_mfma_f32_16x16x32_bf16(k11, qf[i][1], sb, 0, 0, 0);
                        if (lat) { const LAS float* bp = rpbh + (kr - rq + 7) * 31 + boff;
#pragma unroll
                            for (int j = 0; j < 4; ++j) { sa[j] = sa[j] + bp[j] + vm0[j]; sb[j] = sb[j] + bp[16 + j] + vm1[j]; } }
                        float cm = fmaxf(fmaxf(fmaxf(sa[0], sa[1]), fmaxf(sa[2], sa[3])), fmaxf(fmaxf(sb[0], sb[1]), fmaxf(sb[2], sb[3])));
                        cm = fmaxf(cm, shx<16>(cm, lane)); cm = fmaxf(cm, shx<32>(cm, lane));
                        const float mn = fmaxf(m_run[i], cm), al = __builtin_amdgcn_exp2f(m_run[i] - mn); m_run[i] = mn;
                        f32x4 p0, p1; float ps = 0.f;
#pragma unroll
                        for (int j = 0; j < 4; ++j) { p0[j] = __builtin_amdgcn_exp2f(sa[j] - mn); p1[j] = __builtin_amdgcn_exp2f(sb[j] - mn); ps += p0[j] + p1[j]; }
                        l_run[i] = l_run[i] * al + ps;
                        union { u32x4 u; bf16x8 v; } pb; pb.u = g8::pack8(p0, p1);
#pragma unroll
                        for (int db = 0; db < 4; ++db) { o[i][db] = o[i][db] * al; o[i][db] = __builtin_amdgcn_mfma_f32_16x16x32_bf16(vf[db], pb.v, o[i][db], 0, 0, 0); }
                    }
                }
            }
        }
#pragma unroll
        for (int i = 0; i < 4; ++i) {
            float lsum = l_run[i]; lsum += shx<16>(lsum, lane); lsum += shx<32>(lsum, lane);
            const float inv = 1.0f / lsum;
            bf16_t* op = ycat + (size_t)(qrow + 64 * i) * KCAT + 896 + h * 64 + 4 * g;
#pragma unroll
            for (int db = 0; db < 4; ++db) { u32x2 w; w.x = cvt_pk_bf16(o[i][db][0] * inv, o[i][db][1] * inv); w.y = cvt_pk_bf16(o[i][db][2] * inv, o[i][db][3] * inv); *(u32x2*)(op + 16 * db) = w; }
        }
    }
    asm volatile("s_waitcnt vmcnt(0)" ::: "memory");
    __builtin_amdgcn_s_barrier();
}

typedef const __attribute__((address_space(4))) char* KargPtr;
#define INP(i) (*(const float* const volatile __attribute__((address_space(4)))*)(karg + 8 * (i)))
#define WSP(off) (opq(ws) + (off))
#define ctl ((unsigned*)WSP(WS_CTL))
#define mod ((float*)WSP(WS_MOD))
#define ropec ((float*)WSP(WS_ROPE))
#define ropes ((float*)WSP(WS_ROPE + 128 * 16 * 4))
#define s5p ((f32x2*)WSP(WS_S5P))
#define xc ((float*)WSP(WS_XC))
#define ycat ((bf16_t*)WSP(WS_Y))
#define hbuf ycat
#define h2 ycat
#define ebuf ((bf16_t*)WSP(WS_E))
#define ygelu ebuf
#define uvg ((bf16_t*)WSP(WS_UVG))
#define mbuf uvg
#define ybuf0 ((bf16_t*)WSP(WS_Y + 66 * MiB))
#define ybuf1 ((bf16_t*)WSP(WS_Y + 132 * MiB))
#define qk ((bf16_t*)WSP(WS_QK))
#define vt ((bf16_t*)WSP(WS_VT))
#define vtc ((bf16_t*)WSP(WS_VT + 32 * MiB))
#define gates (WSP(WS_G))
#define s5a ((bf16_t*)WSP(WS_S5A))
#define logits ((float*)WSP(WS_LOGITS))
#define ltok ((int*)WSP(WS_LTOK))
#define lw ((float*)WSP(WS_LW))
#define hid ((bf16_t*)WSP(WS_HID))
#define wgu ((bf16_t*)WSP(WS_WGU))
#define wdt ((bf16_t*)WSP(WS_WD))
#define xout (opq(xout_raw))

#define PHASE_IDS() const int lane = opq_v((int)__builtin_amdgcn_mbcnt_hi(~0u, __builtin_amdgcn_mbcnt_lo(~0u, (unsigned)opq_v(0)))); int wave_ = wave0; asm volatile("" : "+s"(wave_)); const int wave = wave_, tid = wave * 64 + lane; \
    const int gw = bid * NWAVES + wave; LAS unsigned char* lds = opq_l(lds0); (void)tid; (void)gw; (void)lds
#define GRID_BAR() do { if constexpr (MULTI) { XcdBarrier b_; b_.bar = (unsigned*)WSP(WS_CTL) + CW_BAR + bli * XCD_BAR_WORDS; b_.x = xb_xcc_id(); b_.st = (volatile LAS unsigned*)(opq_l(lds0) + LDS_MISC); xcd_barrier(b_); } } while (0)
template <unsigned MASK>
__device__ __forceinline__ void layer_body(const int l, KargPtr karg, unsigned char* ws, float* xout_raw, LAS unsigned char* const lds0, const int wave0, const int G, const int bid, const int NGW, const int bli) {
    constexpr bool MULTI = (MASK & (MASK - 1u)) != 0u;
    const int MROWS = (l == 0) ? NROW : NLAT;
#define wb (WSP(WS_WPL) + (size_t)l * WPL_STRIDE)
#define modl (mod + l * 5 * 6144)
        { PROBE_T0(2);
        if (PH(2)) REPS(2) { PHASE_IDS(); const float* xl_ = (l == 0 ? INP(0) : (const float*)xout); const float* xc_ = (l == 0 ? INP(2) : (const float*)xc); const float* gn_ = INP(6) + l * 1024; bf16_t* hb_ = hbuf; const bf16_t* yb_ = ybuf0; const bf16_t* yc_ = ybuf1;
          const float* mdl_ = modl;
          for (int r0 = gw; r0 < NROW; r0 += 2 * NGW) {
            const int r1 = r0 + NGW; const bool two = r1 < NROW;
            const bool lat0 = r0 < NLAT, lat1 = r1 < NLAT;
            const float* xr0 = lat0 ? (xl_ + (size_t)r0 * 1024) : (xc_ + (size_t)(r0 - NLAT) * 1024); const float* xr1 = lat1 ? (xl_ + (size_t)r1 * 1024) : (xc_ + (size_t)(r1 - NLAT) * 1024);
            const float* mr0 = mdl_ + (lat0 ? (r0 >> 13) : 4) * 6144; const float* mr1 = mdl_ + (lat1 ? (r1 >> 13) : 4) * 6144;
            norm_mod_row2(xr0, two ? xr1 : xr0, gn_, mr0, mr0 + 1024, mr1, mr1 + 1024, hb_ + (size_t)r0 * 1024, hb_ + (size_t)(two ? r1 : r0) * 1024, lane, l == 0 ? nullptr : yb_ + (size_t)r0 * 1024, l == 0 ? nullptr : yb_ + (size_t)(two ? r1 : r0) * 1024, mr0 - 6144 * 5 + 5120, mr1 - 6144 * 5 + 5120, yc_ + (size_t)r0 * 1024, yc_ + (size_t)(two ? r1 : r0) * 1024);
          } }
        GRID_BAR(); PROBE_T1(2); }
        { PROBE_T0(3);
        if (PH(3)) REPS(3) { PHASE_IDS();
            g8::SchedDense S; S.init(hbuf, wb + WO_WIN, NROW, NWIN, 1024, 1024, G, bid);
            g8::EpiWin E{WSP(0), lds + LDS_STAGE};
            g8::gemm_run(lds, 1024, 1024, 1024, S, E);
        }
        GRID_BAR(); PROBE_T1(3); }
        { PROBE_T0(4);
        if (PH(4)) REPS(4) { PHASE_IDS();
            g8::SchedS5 S{(const char*)s5a, (const char*)(wb + WO_WEND), 256u * 256u * 2u, G, bid};
            g8::EpiS5E E{ebuf};
            g8::gemm_run(lds, 256, 512, 256, S, E);
        }
        if (PH(5)) REPS(5) { PHASE_IDS();
            const int nunits = (l == 0 ? 264 : 256) * 4;
            LAS bf16_t* vnT = (LAS bf16_t*)lds;
            const float* sw = INP(10) + (size_t)l * 4 * 128 * 128; const float* sbias = INP(11) + l * 4 * 128; const float* sgam = INP(9) + l * 512;
            for (int unit = bid; unit < nunits; unit += G) {
                const int ch = unit >> 2, g = unit & 3; const int r0 = 128 * ch;
                {
                    const int p = tid >> 2, qd = tid & 3; const bf16_t* vp = uvg + (size_t)(r0 + p) * 1024 + 512 + 128 * qd; float s = 0.f, s2 = 0.f;
                    const bf16_t* gp = uvg + (size_t)(r0 + p) * 1024 + 512 + 128 * g + 32 * qd;
                    u32x4 wv[16], wg[4];
#pragma unroll
                    for (int i = 0; i < 16; ++i) wv[i] = *(const u32x4*)(vp + 8 * i);
#pragma unroll
                    for (int i = 0; i < 4; ++i) wg[i] = *(const u32x4*)(gp + 8 * i);
#pragma unroll
                    for (int i = 0; i < 16; ++i) {
#pragma unroll
                        for (int j = 0; j < 4; ++j) { const float a = bf2f(wv[i][j] & 0xffffu), b = bf2f(wv[i][j] >> 16); s += a + b; s2 += a * a + b * b; } }
                    s += shx<1>(s, lane); s += shx<2>(s, lane); s2 += shx<1>(s2, lane); s2 += shx<2>(s2, lane);
                    const float mean = s * (1.0f / 512.0f); const float var = fmaxf(s2 * (1.0f / 512.0f) - mean * mean, 0.f); const float rstd = 1.0f / sqrtf(var + EPSN);
#pragma unroll
                    for (int i = 0; i < 4; ++i) { const u32x4 w = wg[i];
#pragma unroll
                        for (int j = 0; j < 4; ++j) { const int c = 32 * qd + 8 * i + 2 * j;
                            vnT[c * 136 + p] = (bf16_t)f2bf((bf2f(w[j] & 0xffffu) - mean) * rstd * sgam[128 * g + c]);
                            vnT[(c + 1) * 136 + p] = (bf16_t)f2bf((bf2f(w[j] >> 16) - mean) * rstd * sgam[128 * g + c + 1]); } }
                }
                __syncthreads();
                {
                    const int qi = lane & 15, gq = lane >> 4; const int q = 16 * wave + qi;
                    bf16x8 wf[4];
#pragma unroll
                    for (int kk = 0; kk < 4; ++kk) { const float* wp = sw + ((size_t)g * 128 + q) * 128 + 32 * kk + 8 * gq; const f32x4 a = *(const f32x4*)wp, b = *(const f32x4*)(wp + 4);
                        union { u32x4 u; bf16x8 v; } t; t.u = g8::pack8(a, b); wf[kk] = t.v; }
                    const float bq = sbias[g * 128 + q];
                    const bf16_t* up = uvg + (size_t)(r0 + q) * 1024 + 128 * g; bf16_t* op = ycat + (size_t)(r0 + q) * KCAT + 128 * g;
#pragma unroll 2
                    for (int cb = 0; cb < 8; ++cb) { f32x4 d = {0.f, 0.f, 0.f, 0.f};
#pragma unroll
                        for (int kk = 0; kk < 4; ++kk) { const bf16x8 af = *(const LAS bf16x8*)(vnT + (16 * cb + qi) * 136 + 32 * kk + 8 * gq); d = __builtin_amdgcn_mfma_f32_16x16x32_bf16(af, wf[kk], d, 0, 0, 0); }
                        const int c = 16 * cb + 4 * gq; const u32x2 uu = *(const u32x2*)(up + c); u32x2 w;
                        w.x = cvt_pk_bf16(bf2f(uu.x & 0xffffu) * (d[0] + bq), bf2f(uu.x >> 16) * (d[1] + bq)); w.y = cvt_pk_bf16(bf2f(uu.y & 0xffffu) * (d[2] + bq), bf2f(uu.y >> 16) * (d[3] + bq));
                        *(u32x2*)(op + c) = w; }
                }
                __syncthreads();
            }
        }
        GRID_BAR(); PROBE_T1(4); }
        { PROBE_T0(6);
        if (PH(6)) REPS(6) { PHASE_IDS();
            LAS float* rpbS = (LAS float*)lds + 64;
            { const float* rp_ = INP(21) + (size_t)l * 8 * 465; for (int i = tid; i < 8 * 465 + 128; i += NTHR) { const int k = i - 64; ((LAS float*)lds)[i] = (k >= 0 && k < 8 * 465) ? rp_[k] * 1.4426950408889634f : 0.f; } }
            __syncthreads();
            if (bid < 192) {
                const int b = bid / 48, g = (bid % 48) >> 1, dir = bid & 1;
                const f32x2 lam16 = s5p[(size_t)((l * 2 + dir) * 24 + g) * 3136 + 16 * 64 + lane];
                const bf16_t* eb = ebuf + (size_t)g * S5R * 256 + dir * 128 + lane; bf16_t* cb = s5a + (size_t)g * S5R * 512 + 256 + dir * 128 + lane;
                LAS f32x2* segT = (LAS f32x2*)(lds + 16384);
                float cr = 0.f, ci = 0.f, dr = 1.f, di = 0.f;
                for (int jb = 0; jb < 66; jb += 33) { float er[33], ei[33];
#pragma unroll
                    for (int j = 0; j < 33; ++j) { const int k = 66 * wave + jb + j; const int R = (k < 16) ? (2048 + 16 * b + (dir ? 15 - k : k)) : (512 * b + (dir ? 527 - k : k - 16));
                        er[j] = bf2f(eb[(size_t)R * 256]); ei[j] = bf2f(eb[(size_t)R * 256 + 64]); }
#pragma unroll
                    for (int j = 0; j < 33; ++j) { const float nr = lam16.x * cr - lam16.y * ci + er[j], ni = lam16.x * ci + lam16.y * cr + ei[j]; cr = nr; ci = ni;
                        const float tr = dr * lam16.x - di * lam16.y, ti = dr * lam16.y + di * lam16.x; dr = tr; di = ti; } }
                segT[wave * 64 + lane] = (f32x2){cr, ci};
                __syncthreads();
                float ar = 0.f, ai = 0.f;
                for (int s = 0; s < wave; ++s) { const f32x2 t = segT[s * 64 + lane]; const float nr = dr * ar - di * ai + t.x, ni = dr * ai + di * ar + t.y; ar = nr; ai = ni; }
                for (int jb = 0; jb < 66; jb += 33) { float er[33], ei[33];
#pragma unroll
                    for (int j = 0; j < 33; ++j) { const int k = 66 * wave + jb + j; const int R = (k < 16) ? (2048 + 16 * b + (dir ? 15 - k : k)) : (512 * b + (dir ? 527 - k : k - 16));
                        er[j] = bf2f(eb[(size_t)R * 256]); ei[j] = bf2f(eb[(size_t)R * 256 + 64]); }
#pragma unroll
                    for (int j = 0; j < 33; ++j) { const int k = 66 * wave + jb + j; const int R = (k < 16) ? (2048 + 16 * b + (dir ? 15 - k : k)) : (512 * b + (dir ? 527 - k : k - 16));
                        cb[(size_t)R * 512] = (bf16_t)f2bf(ar); cb[(size_t)R * 512 + 64] = (bf16_t)f2bf(ai);
                        const float nr = lam16.x * ar - lam16.y * ai + er[j], ni = lam16.x * ai + lam16.y * ar + ei[j]; ar = nr; ai = ni; } }
            }
            __syncthreads();
            if (l == 0) for (int u2 = (G > 192 ? gw - 192 * NWAVES : gw); u2 < 512; u2 += (G > 192 ? (G - 192) * NWAVES : NGW)) { if (u2 < 0) break;     const int qt = u2 & 15, h = (u2 >> 4) & 7, b = u2 >> 7;
                attn_tile<false>(qk, vt, vtc, ycat, rpbS, b, h, NLAT + b * 256 + 16 * qt, 0, 0, (int)__builtin_amdgcn_mbcnt_hi(~0u, __builtin_amdgcn_mbcnt_lo(~0u, (unsigned)opq_v(0)))); }
            attn_lat_phase(lds, qk, vt, vtc, ycat, rpbS, G, bid, wave, (int)__builtin_amdgcn_mbcnt_hi(~0u, __builtin_amdgcn_mbcnt_lo(~0u, (unsigned)opq_v(0))));
        }
        GRID_BAR(); PROBE_T1(6); }
        { PROBE_T0(7);
        if (PH(7)) REPS(7) { PHASE_IDS();
            g8::SchedS5 S{(const char*)s5a, (const char*)(wb + WO_KT), 256u * 512u * 2u, G, bid};
            g8::EpiS5Y E{ygelu};
            g8::gemm_run(lds, 512, 512, 512, S, E);
        }
        GRID_BAR(); PROBE_T1(7); }
        { PROBE_T0(8);
        if (PH(8)) REPS(8) { PHASE_IDS();
            g8::SchedDense S; S.init(ygelu, wb + WO_GLU, MROWS, 512, 384, 384, G, bid);
            g8::EpiGlu E{ygelu, ycat};
            g8::gemm_run(lds, 384, 384, 384, S, E);
        }
        GRID_BAR(); PROBE_T1(8); }
        { PROBE_T0(9);
        if (PH(9)) REPS(9) { PHASE_IDS();
            g8::SchedMerge S; S.init(ycat, wb + WO_WCAT, MROWS, G, bid); g8::EpiMerge E{gates, mbuf}; g8::gemm_run(lds, KCAT, KCAT, KCAT, S, E);
        }
        GRID_BAR(); PROBE_T1(9); }
        { PROBE_T0(10);
        if (PH(10)) REPS(10) { PHASE_IDS();
            g8::SchedDense S; S.init(mbuf, wb + WO_WOUT, MROWS, 1024, 1024, 1024, G, bid);
            g8::EpiWout E{(l == 0 && rep_ == 0) ? INP(0) : (const float*)xout, (l == 0 && rep_ == 0) ? INP(2) : (const float*)xc, xout, xc, modl, rep_ == 0 ? 1.f : 0.f};
            g8::gemm_run(lds, 1024, 1024, 1024, S, E);
        }
        GRID_BAR(); PROBE_T1(10); }
        { PROBE_T0(11);
        if (PH(11)) REPS(11) { PHASE_IDS(); const float* xl_ = xout; const float* xc_ = xc; const float* gn_ = INP(7) + l * 1024; bf16_t* hb_ = h2;
          const float* mdl_ = modl;
          for (int r0 = gw; r0 < MROWS; r0 += 2 * NGW) {
            const int r1 = r0 + NGW; const bool two = r1 < MROWS;
            const bool lat0 = r0 < NLAT, lat1 = r1 < NLAT;
            const float* xr0 = lat0 ? (xl_ + (size_t)r0 * 1024) : (xc_ + (size_t)(r0 - NLAT) * 1024); const float* xr1 = lat1 ? (xl_ + (size_t)r1 * 1024) : (xc_ + (size_t)(r1 - NLAT) * 1024);
            const float* mr0 = mdl_ + (lat0 ? (r0 >> 13) : 4) * 6144; const float* mr1 = mdl_ + (lat1 ? (r1 >> 13) : 4) * 6144;
            norm_mod_row2(xr0, two ? xr1 : xr0, gn_, mr0 + 3072, mr0 + 4096, mr1 + 3072, mr1 + 4096, hb_ + (size_t)r0 * 1024, hb_ + (size_t)(two ? r1 : r0) * 1024, lane, nullptr, nullptr);
          } }
        GRID_BAR(); PROBE_T1(11); }
        { PROBE_T0(12);
        if (PH(12)) { PHASE_IDS();
            g8::SchedDense S; S.init(h2, wb + WO_WR, MROWS, 256, 1024, 1024, G, bid);
            g8::EpiLogits E{logits};
            g8::gemm_run(lds, 1024, 1024, 1024, S, E);
            { g8::GUnit ru; for (int ui_ = 0; S.next(ui_, ru); ++ui_) {
            unsigned* cntg = ctl + CW_CNT + l * 64 * 32; const float* rgb = INP(27) + l * 4; const float* reb = INP(29) + l * 32; const float* lg_ = logits; int* lt_ = ltok; float* lw_ = lw;
            LAS unsigned* hist = (LAS unsigned*)lds; LAS unsigned* lbase = hist + 64;
            __syncthreads(); if (tid < 64) hist[tid] = 0u;
            __syncthreads();
            const int r = ru.pm * 256 + tid; const bool act = tid < 256;
            int L0 = 0, L1 = 0; unsigned s0 = 0, s1 = 0; float cw0 = 0.f, cw1 = 0.f;
            if (act) {
                const float* lp = lg_ + (size_t)r * 128; float v[72];
#pragma unroll
                for (int i = 0; i < 18; ++i) { const f32x4 t = *(const f32x4*)(lp + 4 * i); v[4 * i] = t.x; v[4 * i + 1] = t.y; v[4 * i + 2] = t.z; v[4 * i + 3] = t.w; }
                float lg[4]; int grp = 0; float gmax;
#pragma unroll
                for (int j = 0; j < 4; ++j) lg[j] = v[j] + v[36 + j] + rgb[j];
                gmax = lg[0];
#pragma unroll
                for (int j = 1; j < 4; ++j) if (lg[j] > gmax) { gmax = lg[j]; grp = j; }
                float gs = 0.f;
#pragma unroll
                for (int j = 0; j < 4; ++j) gs += __expf(lg[j] - gmax);
                const float gwt = 1.0f / gs;
                float le[8];
#pragma unroll
                for (int j = 0; j < 8; ++j) { float a = 0.f;
#pragma unroll
                    for (int q = 0; q < 4; ++q) a = (grp == q) ? (v[4 + 8 * q + j] + v[40 + 8 * q + j]) : a;
                    le[j] = a + reb[8 * grp + j]; }
                int i1 = 0; float v1 = le[0];
#pragma unroll
                for (int j = 1; j < 8; ++j) if (le[j] > v1) { v1 = le[j]; i1 = j; }
                int i2 = -1; float v2 = -3.4e38f;
#pragma unroll
                for (int j = 0; j < 8; ++j) if (j != i1 && le[j] > v2) { v2 = le[j]; i2 = j; }
                const float e2 = __expf(v2 - v1); const float w1 = 1.0f / (1.0f + e2), w2 = e2 * w1;
                L0 = 8 * grp + i1; L1 = 32 + 8 * grp + i2; cw0 = gwt * w1; cw1 = gwt * w2;
                s0 = __hip_atomic_fetch_add(hist + L0, 1u, __ATOMIC_RELAXED, __HIP_MEMORY_SCOPE_WORKGROUP); s1 = __hip_atomic_fetch_add(hist + L1, 1u, __ATOMIC_RELAXED, __HIP_MEMORY_SCOPE_WORKGROUP);
            }
            __syncthreads();
            if (tid < 64) { const unsigned c = hist[tid]; lbase[tid] = c ? atomicAdd(cntg + tid * 32, c) : 0u; }
            __syncthreads();
            if (act) { const unsigned p0 = lbase[L0] + s0, p1 = lbase[L1] + s1;
                lt_[(size_t)L0 * LCAP + p0] = r; lw_[(size_t)L0 * LCAP + p0] = cw0;
                lt_[(size_t)L1 * LCAP + p1] = r; lw_[(size_t)L1 * LCAP + p1] = cw1; }
            } }
        }
        if (PH(12)) REPS(12) { PHASE_IDS();
            LAS float* scr = (LAS float*)(lds + wave * 8448);
            const int nu_ = MROWS / 256; const int w0_ = (G > nu_) ? (bid - nu_) * NWAVES + wave : gw, nw_ = (G > nu_) ? (G - nu_) * NWAVES : NGW;
            if (w0_ >= 0) for (int it = w0_; it < 32 * 384; it += nw_) { const int e = it / 384; int r = it % 384;
                if (r < 256) { const int up = r >> 7; r &= 127; const int kb = r >> 3, nb = r & 7, n0 = 32 * nb;
                    tr_item((up ? INP(31) : INP(30)) + ((size_t)(l * 32 + e) * 1024) * 256, 256, 64 * kb, n0, wgu + (size_t)e * 512 * 1024, 1024, 256 * (n0 >> 7) + 128 * up + (n0 & 127), 64 * kb, scr, lane); }
                else { r -= 256; const int kb = r >> 5, nb = r & 31; tr_item(INP(32) + ((size_t)(l * 32 + e) * 256) * 1024, 1024, 64 * kb, 32 * nb, wdt + (size_t)e * 1024 * 256, 256, 32 * nb, 64 * kb, scr, lane); }
            }
        }
        GRID_BAR(); PROBE_T1(12); }
#define MOE_TABLES() LAS int* tstart = (LAS int*)(lds + LDS_MISC) + 16; LAS int* lcnt = (LAS int*)(lds + LDS_MISC) + 96; \
            if (tid < 64) lcnt[tid] = (int)__hip_atomic_load(ctl + CW_CNT + (l * 64 + tid) * 32, __ATOMIC_RELAXED, __HIP_MEMORY_SCOPE_AGENT); \
            __syncthreads(); \
            if (tid == 0) { int s = 0; for (int j = 0; j < 64; ++j) { tstart[j] = s; s += (lcnt[j] + 255) >> 8; } tstart[64] = s; } \
            __syncthreads()
        { PROBE_T0(14);
        if (PH(14)) REPS(14) { PHASE_IDS(); MOE_TABLES();
            g8::SchedMoeUp S{(const char*)h2, (const char*)wgu, ltok, tstart, lcnt, G, bid};
            g8::EpiMoeUp E{hid, lw, lcnt};
            g8::gemm_run(lds, 1024, 1024, 1024, S, E);
        }
        GRID_BAR(); PROBE_T1(14); }
        { PROBE_T0(15);
        if (PH(15)) { PHASE_IDS(); MOE_TABLES();
            g8::SchedMoeDown S{(const char*)hid, (const char*)wdt, tstart, G, bid};
            g8::EpiMoeDown E{ybuf0, ybuf1, ltok, lcnt};
            g8::gemm_run(lds, 256, 256, 256, S, E);
        }
        GRID_BAR(); PROBE_T1(15); }
}

template <unsigned MASK>
__global__ void __launch_bounds__(NTHR, 2) hybrid_fwd(Params P, int l0, int l1, int bli) {
    constexpr bool MULTI = (MASK & (MASK - 1u)) != 0u;
    extern __shared__ __attribute__((aligned(16))) unsigned char lds_raw[];
    LAS unsigned char* const lds0 = (LAS unsigned char*)lds_raw; LAS unsigned char* lds = lds0;
    volatile LAS unsigned* MISC = (volatile LAS unsigned*)(lds + LDS_MISC);
    const int tid = threadIdx.x, lane = tid & 63, wave = __builtin_amdgcn_readfirstlane(tid >> 6);
    const int G = gridDim.x, bid = blockIdx.x;
    const int gw = bid * NWAVES + wave, NGW = G * NWAVES;
    KargPtr karg = (KargPtr)__builtin_amdgcn_kernarg_segment_ptr();
    unsigned char* ws = *(unsigned char* const volatile __attribute__((address_space(4)))*)(karg + 8 * 35);
    for (int u = tid; u < 256; u += NTHR) MISC[u] = 0u;
    __syncthreads();
    if constexpr (MULTI) (void)xcd_barrier_post((unsigned*)(ws + WS_CTL) + CW_BAR + bli * XCD_BAR_WORDS, MISC);
    const int wave0 = wave;

    float* xout_raw = *(float* const volatile __attribute__((address_space(4)))*)(karg + 8 * 34);

    if (PH(0)) REPS(0) {
        LAS float* scr = (LAS float*)(lds + wave * 8448);
        constexpr int IT_WIN = 16 * 192, IT_A = 8 * 32, IT_B = 6 * 32, IT_C = 8 * 32, IT_O = 16 * 32, IT_G = 6 * 16, IT_L = IT_WIN + IT_A + IT_B + IT_C + IT_O + IT_G;
        for (int it = gw; it < 2 * IT_L; it += NGW) {
            const int l = it / IT_L; int r = it % IT_L; unsigned char* wbp = ws + WS_WPL + (size_t)l * WPL_STRIDE;
            if (r < IT_WIN) { const int kb = r / 192, nb = r % 192, n0 = 32 * nb; int src = -1;
                if (n0 < 1024) src = n0; else if (n0 < 2560) src = 1408 + (n0 - 1024); else if (n0 < 5632) src = 2944 + (n0 - 2560); else if (n0 < 6016) src = 1024 + (n0 - 5632);
                tr_item(src >= 0 ? INP(8) + (size_t)l * 1024 * 6016 : nullptr, 6016, 64 * kb, src, (bf16_t*)(wbp + WO_WIN), 1024, n0, 64 * kb, scr, lane); continue; } r -= IT_WIN;
            if (r < IT_A) { tr_item(INP(22) + (size_t)l * 512 * 1024, 1024, 64 * (r / 32), 32 * (r % 32), (bf16_t*)(wbp + WO_WCAT), KCAT, 32 * (r % 32), 64 * (r / 32), scr, lane); continue; } r -= IT_A;
            if (r < IT_B) { tr_item(INP(23) + (size_t)l * 384 * 1024, 1024, 64 * (r / 32), 32 * (r % 32), (bf16_t*)(wbp + WO_WCAT), KCAT, 32 * (r % 32), 512 + 64 * (r / 32), scr, lane); continue; } r -= IT_B;
            if (r < IT_C) { tr_item(INP(24) + (size_t)l * 512 * 1024, 1024, 64 * (r / 32), 32 * (r % 32), (bf16_t*)(wbp + WO_WCAT), KCAT, 32 * (r % 32), 896 + 64 * (r / 32), scr, lane); continue; } r -= IT_C;
            if (r < IT_O) { tr_item(INP(25) + (size_t)l * 1024 * 1024, 1024, 64 * (r / 32), 32 * (r % 32), (bf16_t*)(wbp + WO_WOUT), 1024, 32 * (r % 32), 64 * (r / 32), scr, lane); continue; } r -= IT_O;
            { const int kb = r / 16, nb = r % 16; tr_item(nb < 12 ? INP(20) + (size_t)l * 384 * 384 : nullptr, 384, 64 * kb, 32 * nb, (bf16_t*)(wbp + WO_GLU), 384, 32 * nb, 64 * kb, scr, lane); }
        }
        const float* rgw = INP(26); const float* rew = INP(28);
        for (int idx = bid * NTHR + tid; idx < 2 * 256 * 1024; idx += G * NTHR) {
            const int l = idx >> 18, n = (idx >> 10) & 255, k = idx & 1023; float w = 0.f; int lo = 0, j = n;
            if (n >= 36 && n < 72) { lo = 1; j = n - 36; }
            if (n < 72) w = j < 4 ? rgw[(size_t)l * 1024 * 4 + k * 4 + j] : rew[(size_t)l * 1024 * 32 + k * 32 + (j - 4)];
            const unsigned hb = f2bf(w); const float res = lo ? (w - bf2f(hb)) : 0.f;
            ((bf16_t*)(ws + WS_WPL + (size_t)l * WPL_STRIDE + WO_WR))[n * 1024 + k] = (bf16_t)(lo ? f2bf(res) : hb);
        }
        for (int idx = bid * NTHR + tid; idx < 128 * 16; idx += G * NTHR) {
            const int pos = idx >> 4, f = idx & 15; const float inv = powf(10000.0f, -(float)f / 16.0f); const float ang = (float)pos * inv;
            ropec[idx] = cosf(ang); ropes[idx] = sinf(ang);
        }
        const float* s5bre = INP(15); const float* s5bim = INP(16); const float* s5cre = INP(17); const float* s5cim = INP(18);
        for (int e = bid * NTHR + tid; e < 17 * 2 * 2 * 24 * 64; e += G * NTHR) {
            const int d = e / 6144, idx = e - d * 6144; const int p = idx & 63, ldg = idx >> 6;
            const float dt = expf(INP(14)[ldg]); const float zr = INP(12)[idx] * dt, zi = INP(13)[idx] * dt; const float ex = expf(zr * (float)d);
            s5p[(size_t)ldg * 3136 + d * 64 + p] = (f32x2){ex * cosf(zi * (float)d), ex * sinf(zi * (float)d)};
        }
        for (int idx = bid * NTHR + tid; idx < 2 * 2 * 24 * 64; idx += G * NTHR) {
            const int p = idx & 63, ldg = idx >> 6;
            const float are = INP(12)[idx], aim = INP(13)[idx]; const float dt = expf(INP(14)[ldg]);
            const float zr = are * dt, zi = aim * dt;
            f32x2* base = s5p + (size_t)ldg * 3136;
            const float e1 = expf(zr), lr = e1 * cosf(zi) - 1.0f, li = e1 * sinf(zi); const float den = 1.0f / (are * are + aim * aim);
            const float cr = (lr * are + li * aim) * den, ci = (li * are - lr * aim) * den;
            for (int c = 0; c < 16; ++c) { const float br = s5bre[(size_t)idx * 16 + c], bi = s5bim[(size_t)idx * 16 + c];
                base[1088 + p * 16 + c] = (f32x2){cr * br - ci * bi, cr * bi + ci * br};
                base[2112 + c * 64 + p] = (f32x2){s5cre[((size_t)ldg * 16 + c) * 64 + p], s5cim[((size_t)ldg * 16 + c) * 64 + p]}; }
        }
        __syncthreads();
        for (int unit = bid; unit < 2 * 96; unit += G) {
            const int l = unit / 96, n0 = 64 * (unit % 96);
            LAS float* sv = (LAS float*)lds; LAS float* part = sv + 5 * 1024;
            const float* cv = INP(1); const float* ccv = INP(3);
            for (int i = tid; i < 5 * 1024; i += NTHR) { const int m = i >> 10, k = i & 1023; const float c = m < 4 ? cv[m * 1024 + k] : ccv[k]; sv[i] = c * sigmoidf_(c); }
            __syncthreads();
            float a[5] = {0.f, 0.f, 0.f, 0.f, 0.f};
            const float* wp = INP(4) + (size_t)l * 1024 * 6144 + n0 + lane;
            for (int kb = wave * 128; kb < wave * 128 + 128; kb += 32) { float wv[32];
#pragma unroll
                for (int j = 0; j < 32; ++j) wv[j] = wp[(size_t)(kb + j) * 6144];
#pragma unroll
                for (int j = 0; j < 32; ++j) {
#pragma unroll
                    for (int m = 0; m < 5; ++m) a[m] += sv[m * 1024 + kb + j] * wv[j]; } }
#pragma unroll
            for (int m = 0; m < 5; ++m) part[(wave * 5 + m) * 64 + lane] = a[m];
            __syncthreads();
            if (tid < 320) { const int m = tid >> 6, n = tid & 63; float s = 0.f;
#pragma unroll
                for (int w = 0; w < 8; ++w) s += part[(w * 5 + m) * 64 + n];
                mod[(l * 5 + m) * 6144 + n0 + n] = s + INP(5)[l * 6144 + n0 + n]; }
            __syncthreads();
        }
    }
    GRID_BAR();
    if (PH(1)) REPS(1) for (int unit = bid; unit < 192; unit += G) {
        const int l = unit / 96, g = (unit % 96) >> 2, qt = unit & 3;
        LAS f32x2* prm = (LAS f32x2*)lds;
        LAS float* Gt = (LAS float*)(lds + 2 * 3136 * 8);
        { const f32x2* pf = s5p + (size_t)((l * 2 + 0) * 24 + g) * 3136; const f32x2* pr = s5p + (size_t)((l * 2 + 1) * 24 + g) * 3136;
          for (int i = tid; i < 3136; i += NTHR) { prm[i] = pf[i]; prm[3136 + i] = pr[i]; } }
        __syncthreads();
        for (int e = tid; e < 2048; e += NTHR) { const int dir = e >> 10, d = (e >> 6) & 15, co = 4 * qt + ((e >> 4) & 3), ci = e & 15; const LAS f32x2* pp = prm + dir * 3136; float s = 0.f;
#pragma unroll 8
            for (int p = 0; p < 64; ++p) { const f32x2 c = pp[2112 + co * 64 + p], w = pp[d * 64 + p], bb = pp[1088 + p * 16 + ci];
                const float tr = c.x * w.x - c.y * w.y, ti = c.x * w.y + c.y * w.x; s += tr * bb.x - ti * bb.y; }
            Gt[e] = s; }
        __syncthreads();
        unsigned* kt = (unsigned*)((bf16_t*)(ws + WS_WPL + (size_t)l * WPL_STRIDE + WO_KT) + (size_t)g * 256 * 512);
        unsigned* we = (unsigned*)((bf16_t*)(ws + WS_WPL + (size_t)l * WPL_STRIDE + WO_WEND) + (size_t)g * 256 * 256);
        const float* s5d = INP(19) + l * 384 + 16 * g;
        for (int idx = tid; idx < 64 * 256; idx += NTHR) { const int rr = idx >> 8, k0 = (idx & 255) * 2, m = rr >> 2, cq = rr & 3, co = 4 * qt + cq, n = 16 * m + co; float v[2];
#pragma unroll
            for (int j = 0; j < 2; ++j) { const int k = k0 + j; float x = 0.f;
                if (k < 256) { const int mp = k >> 4, ci = k & 15;
                    if (mp <= m) x += Gt[(((m - mp) * 4 + cq) * 16) + ci];
                    if (mp >= m) x += Gt[1024 + (((mp - m) * 4 + cq) * 16) + ci];
                    if (mp == m && co == ci) x += s5d[co];
                } else { const int q = (k - 256) & 127, dir = (k - 256) >> 7, p = q & 63, im = q >> 6; const LAS f32x2* pp = prm + dir * 3136;
                    const f32x2 c = pp[2112 + co * 64 + p], w = pp[(dir ? (16 - m) : (m + 1)) * 64 + p];
                    x = im ? -(c.x * w.y + c.y * w.x) : (c.x * w.x - c.y * w.y); }
                v[j] = x; }
            kt[(n * 512 + k0) >> 1] = f2bf(v[0]) | (f2bf(v[1]) << 16); }
        for (int idx = tid; idx < 64 * 128; idx += NTHR) { const int n = 64 * qt + (idx >> 7), k0 = (idx & 127) * 2, dir = n >> 7, p = n & 63, im = (n >> 6) & 1; const LAS f32x2* pp = prm + dir * 3136; float v[2];
#pragma unroll
            for (int j = 0; j < 2; ++j) { const int k = k0 + j, mp = k >> 4, ci = k & 15; const f32x2 w = pp[(dir ? mp : (15 - mp)) * 64 + p], bb = pp[1088 + p * 16 + ci];
                v[j] = im ? (w.x * bb.y + w.y * bb.x) : (w.x * bb.x - w.y * bb.y); }
            we[(n * 256 + k0) >> 1] = f2bf(v[0]) | (f2bf(v[1]) << 16); }
        __syncthreads();
    }

    if constexpr (MASK == ALL_PHASES) { layer_body<MASK>(0, karg, ws, xout_raw, lds0, wave, G, bid, NGW, bli); layer_body<MASK>(1, karg, ws, xout_raw, lds0, wave, G, bid, NGW, bli); }
    else { for (int l = l0; l < l1; ++l) layer_body<MASK>(l, karg, ws, xout_raw, lds0, wave, G, bid, NGW, bli); }
    if (PROBE_MASK != 0u) { GRID_BAR(); const unsigned long long acc_ = *(volatile unsigned long long*)(ws + WS_CTL + 4096); const unsigned long long t0_ = __builtin_amdgcn_s_memrealtime(); while (__builtin_amdgcn_s_memrealtime() - t0_ < 4ull * acc_) __builtin_amdgcn_s_sleep(8); }
#ifdef EXTRA_BARS
    for (int i_ = 0; i_ < EXTRA_BARS; ++i_) GRID_BAR();
#endif
    if (PH(17)) { PHASE_IDS(); const float* fg_ = INP(33); float* xo_ = xout; const bf16_t* yb_ = ybuf0; const bf16_t* yc_ = ybuf1; const float* g2_ = mod + 5 * 6144 + 5120;
    for (int r = gw; r < NLAT; r += NGW) {
        float* xr = xo_ + (size_t)r * 1024; f32x4* xp = (f32x4*)xr + lane; f32x4 v[4]; float s = 0.f;
#pragma unroll
        for (int j = 0; j < 4; ++j) { v[j] = xp[64 * j]; const u32x2 yy = *(const u32x2*)(yb_ + (size_t)r * 1024 + 4 * lane + 256 * j), zz = *(const u32x2*)(yc_ + (size_t)r * 1024 + 4 * lane + 256 * j); const f32x4 g2 = *(const f32x4*)(g2_ + (r >> 13) * 6144 + 4 * lane + 256 * j); v[j].x += g2.x * (bf2f(yy.x & 0xffffu) + bf2f(zz.x & 0xffffu)); v[j].y += g2.y * (bf2f(yy.x >> 16) + bf2f(zz.x >> 16)); v[j].z += g2.z * (bf2f(yy.y & 0xffffu) + bf2f(zz.y & 0xffffu)); v[j].w += g2.w * (bf2f(yy.y >> 16) + bf2f(zz.y >> 16));
            s += (v[j].x * v[j].x + v[j].y * v[j].y) + (v[j].z * v[j].z + v[j].w * v[j].w); }
        const float rr = 1.0f / sqrtf(wave_sum(s, lane) * (1.0f / DM) + EPSN);
#pragma unroll
        for (int j = 0; j < 4; ++j) { const f32x4 g = *(const f32x4*)(fg_ + 4 * lane + 256 * j); xp[64 * j] = v[j] * rr * g; }
    } }
}

template <unsigned MASK> static void launch_ph(const Params& p, int l0, int l1, int grid, hipStream_t s) {
    static bool attr = false;
    if (!attr) { if (hipFuncSetAttribute((const void*)hybrid_fwd<MASK>, hipFuncAttributeMaxDynamicSharedMemorySize, LDS_BYTES) != hipSuccess) fprintf(stderr, "kernel_launch: hipFuncSetAttribute failed\n"); attr = true; }
    hipLaunchKernelGGL(hybrid_fwd<MASK>, dim3(grid), dim3(NTHR), LDS_BYTES, s, p, l0, l1, 0);
}
extern "C" void kernel_launch(void* const* d_in, const int* in_sizes, int n_in, void* d_out, int out_size, void* d_ws, size_t ws_size, hipStream_t stream) {
    static int grid = 0;
    if (grid == 0) {
        if (n_in != 34 || out_size != NLAT * DM || ws_size < WS_END) { fprintf(stderr, "kernel_launch: unexpected problem (n_in %d, out %d, ws %zu)\n", n_in, out_size, ws_size); grid = -1; return; }
        int dev = 0, cus = 0;
        if (hipGetDevice(&dev) != hipSuccess || hipDeviceGetAttribute(&cus, hipDeviceAttributeMultiprocessorCount, dev) != hipSuccess) { grid = -1; return; }
        grid = cus;
    }
    if (grid < 0) return;
    (void)hipMemsetAsync((char*)d_ws + WS_CTL, 0, CTL_BYTES, stream);
    Params p{};
    for (int i = 0; i < 34; ++i) p.in[i] = (const float*)d_in[i];
    p.out = (float*)d_out; p.ws = (unsigned char*)d_ws;
#if N_LAUNCHES == 1
    {
        static bool q = false;
        if (!q) { q = true; int per_cu = 0; (void)hipFuncSetAttribute((const void*)hybrid_fwd<ALL_PHASES>, hipFuncAttributeMaxDynamicSharedMemorySize, LDS_BYTES);
            if (hipOccupancyMaxActiveBlocksPerMultiprocessor(&per_cu, (const void*)hybrid_fwd<ALL_PHASES>, NTHR, LDS_BYTES) != hipSuccess || per_cu < 1) fprintf(stderr, "kernel_launch: occupancy query says %d\n", per_cu);
            (void)hipGetLastError(); }
    }
    launch_ph<ALL_PHASES>(p, 0, 2, grid, stream);
#else
    launch_ph<1u << 0>(p, 0, 0, grid, stream);
    launch_ph<1u << 1>(p, 0, 0, grid, stream);
    for (int l = 0; l < 2; ++l) {
        launch_ph<1u << 2>(p, l, l + 1, grid, stream);  launch_ph<1u << 3>(p, l, l + 1, grid, stream);  launch_ph<1u << 4>(p, l, l + 1, grid, stream);
        launch_ph<1u << 5>(p, l, l + 1, grid, stream);  launch_ph<1u << 6>(p, l, l + 1, grid, stream);  launch_ph<1u << 7>(p, l, l + 1, grid, stream);
        launch_ph<1u << 8>(p, l, l + 1, grid, stream);  launch_ph<1u << 9>(p, l, l + 1, grid, stream);  launch_ph<1u << 10>(p, l, l + 1, grid, stream);
        launch_ph<1u << 11>(p, l, l + 1, grid, stream); launch_ph<1u << 12>(p, l, l + 1, grid, stream); launch_ph<1u << 13>(p, l, l + 1, grid, stream);
        launch_ph<1u << 14>(p, l, l + 1, grid, stream); launch_ph<1u << 15>(p, l, l + 1, grid, stream); launch_ph<1u << 16>(p, l, l + 1, grid, stream);
    }
    launch_ph<1u << 17>(p, 0, 0, grid, stream);
#endif
}
```

```cpp
#include <hip/hip_runtime.h>
#include <cstdio>
#include <cstdint>

#define LAS __attribute__((address_space(3)))
typedef unsigned short bf16_t;
typedef short bf16x8 __attribute__((ext_vector_type(8)));
typedef float f32x4 __attribute__((ext_vector_type(4)));
typedef float f32x2 __attribute__((ext_vector_type(2)));
typedef unsigned u32x4 __attribute__((ext_vector_type(4)));
typedef unsigned u32x2 __attribute__((ext_vector_type(2)));

#ifndef N_LAUNCHES
#define N_LAUNCHES 1
#endif
#define PH(k) ((MASK >> (k)) & 1u)
#ifndef DUP_MASK
#define DUP_MASK 0u
#endif
#ifndef PROBE_MASK
#define PROBE_MASK 0u
#endif
#define PROBE_ON(k) (((((unsigned)PROBE_MASK) >> (k)) & 1u) != 0u)
#define PROBE_T0(k) unsigned long long pt0_ = 0; if (PROBE_ON(k) && bid == 0 && wave0 == 0) pt0_ = __builtin_amdgcn_s_memrealtime()
#define PROBE_T1(k) if (PROBE_ON(k) && bid == 0 && wave0 == 0) { const unsigned long long d_ = __builtin_amdgcn_s_memrealtime() - pt0_; if (__builtin_amdgcn_mbcnt_hi(~0u, __builtin_amdgcn_mbcnt_lo(~0u, 0u)) == 0) { unsigned long long* pa_ = (unsigned long long*)(WSP(WS_CTL) + 4096); *pa_ += d_; } }
#define REPS(k) for (int rep_ = 0; rep_ < 1 + (int)((((unsigned)DUP_MASK) >> (k)) & 1u); ++rep_)
constexpr unsigned ALL_PHASES = 0x3ffffu;

constexpr int DM = 1024, SEQ = 8192, CTXL = 256, NLAT = 32768, NCTX = 1024, NROW = 33792;
constexpr int NWIN = 6144, KCAT = 1408, S5R = 2304, S5RV = 2112, LCAP = 33792;
constexpr float EPSN = 1e-6f;
constexpr int NWAVES = 8, NTHR = 512;

constexpr size_t MiB = 1u << 20;
constexpr size_t WS_CTL = 0, CTL_BYTES = MiB;
constexpr size_t WS_MOD = 1 * MiB;
constexpr size_t WS_ROPE = 1 * MiB + 256 * 1024;
constexpr size_t WS_S5P = 2 * MiB;
constexpr size_t WS_WPL = 6 * MiB, WPL_STRIDE = 27 * MiB;
constexpr size_t WO_WIN = 0, WO_WCAT = 12 * MiB, WO_WOUT = 15 * MiB, WO_WR = 17 * MiB, WO_GLU = 17 * MiB + 512 * 1024, WO_KT = 18 * MiB, WO_WEND = 24 * MiB;
constexpr size_t WS_XC = 60 * MiB;
constexpr size_t WS_Y = 64 * MiB;
constexpr size_t WS_E = 155 * MiB;
constexpr size_t WS_UVG = 182 * MiB;
constexpr size_t WS_QK = 248 * MiB;
constexpr size_t WS_VT = 314 * MiB;
constexpr size_t WS_G = 347 * MiB;
constexpr size_t WS_S5A = 446 * MiB;
constexpr size_t WS_END = 500 * MiB;
constexpr size_t WS_LOGITS = WS_QK, WS_LTOK = WS_QK + 20 * MiB, WS_LW = WS_QK + 30 * MiB;
constexpr size_t WS_HID = WS_G, WS_WGU = WS_G + 42 * MiB, WS_WD = WS_G + 74 * MiB;
constexpr int CW_BAR = 4096, CW_CNT = 8192;

constexpr int LDS_STAGE = 131072, LDS_BYTES = 155648, LDS_MISC = LDS_BYTES - 1024;

__device__ __forceinline__ unsigned f2bf(float f) { unsigned u = __builtin_bit_cast(unsigned, f); return (u + 0x7fffu + ((u >> 16) & 1u)) >> 16; }
__device__ __forceinline__ float bf2f(unsigned b) { return __builtin_bit_cast(float, b << 16); }
__device__ __forceinline__ unsigned cvt_pk_bf16(float lo, float hi) { unsigned r; asm volatile("v_cvt_pk_bf16_f32 %0, %1, %2" : "=v"(r) : "v"(lo), "v"(hi)); return r; }
template <int M> __device__ __forceinline__ float shx(float v, int lane) {
    if constexpr (M < 32) return __builtin_bit_cast(float, __builtin_amdgcn_ds_swizzle(__builtin_bit_cast(int, v), (M << 10) | 0x1f));
    else return __builtin_bit_cast(float, __builtin_amdgcn_ds_bpermute((lane ^ 32) << 2, __builtin_bit_cast(int, v)));
}
__device__ __forceinline__ float wave_sum(float v, int lane) {
    v += shx<1>(v, lane); v += shx<2>(v, lane); v += shx<4>(v, lane); v += shx<8>(v, lane); v += shx<16>(v, lane); v += shx<32>(v, lane);
    return v;
}
__device__ __forceinline__ float gelu_tanh(float x) { const float w = x * __builtin_fmaf(x * x, -0.044715f * 1.5957691216f * 1.4426950408889634f, -1.5957691216f * 1.4426950408889634f); return x * __builtin_amdgcn_rcpf(1.0f + __builtin_amdgcn_exp2f(w)); }
__device__ __forceinline__ float sigmoidf_(float x) { return __builtin_amdgcn_rcpf(1.0f + __expf(-x)); }
#define LDS_WAIT() asm volatile("s_waitcnt lgkmcnt(0)" ::: "memory")
template <class T> __device__ __forceinline__ T* opq(T* p) { asm volatile("" : "+s"(p)); return p; }
__device__ __forceinline__ int opq_v(int v) { asm volatile("" : "+v"(v)); return v; }
__device__ __forceinline__ unsigned opq_u(unsigned v) { asm volatile("" : "+v"(v)); return v; }
__device__ __forceinline__ LAS unsigned char* opq_l(LAS unsigned char* p) { unsigned v = (unsigned)(size_t)p; asm volatile("" : "+s"(v)); return (LAS unsigned char*)(size_t)v; }

#define XB_TMO      128
#define XB_XCNT(j)  (256  + 64 * (j))
#define XB_XSUB(j)  (1280 + 64 * (j))
#define XB_XGEN(j)  (2304 + 64 * (j))
#define XB_TOP      3328
#define XB_TOPGEN   3392
#define XCD_BAR_WORDS 3456
#define XB_SPIN_CAP (1u << 18)
__device__ __forceinline__ unsigned xb_ld(unsigned* p)              { return __hip_atomic_load(p, __ATOMIC_RELAXED, __HIP_MEMORY_SCOPE_AGENT); }
__device__ __forceinline__ unsigned xb_add(unsigned* p, unsigned v) { return __hip_atomic_fetch_add(p, v, __ATOMIC_RELAXED, __HIP_MEMORY_SCOPE_AGENT); }
__device__ __forceinline__ unsigned xb_xcc_id() { return (unsigned)__builtin_amdgcn_s_getreg((3 << 11) | 20) & 0xFu; }
#define XB_SPIN(cond, bar) do { unsigned _sp = 0; while (cond) { __builtin_amdgcn_s_sleep(1); \
    if ((++_sp & 255u) == 0u) { if (xb_ld(&(bar)[XB_TMO])) break; if (_sp > XB_SPIN_CAP) { atomicAdd(&(bar)[XB_TMO], 1u); break; } } } } while (0)
struct XcdBarrier { unsigned* bar; unsigned x; volatile LAS unsigned* st; };
__device__ __forceinline__ XcdBarrier xcd_barrier_post(unsigned* bar, volatile LAS unsigned* st) {
    XcdBarrier b; b.bar = bar; b.x = xb_xcc_id(); b.st = st;
    if (threadIdx.x == 0) (void)xb_add(&bar[XB_XCNT(b.x)], 1u);
    return b;
}
__device__ __forceinline__ void xcd_barrier_complete(unsigned* bar, unsigned x, unsigned& nloc, unsigned& nx) {
    const unsigned G = gridDim.x * gridDim.y * gridDim.z;
    unsigned sum, cnt, mine, sp = 0u;
    for (;;) {
        sum = 0u; cnt = 0u; mine = 0u;
#pragma unroll
        for (unsigned j = 0; j < 16; ++j) { const unsigned c = xb_ld(&bar[XB_XCNT(j)]); sum += c; cnt += (c > 0u) ? 1u : 0u; mine = (j == x) ? c : mine; }
        if (sum == G) break;
        __builtin_amdgcn_s_sleep(1);
        if ((++sp & 255u) == 0u) { if (xb_ld(&bar[XB_TMO])) break; if (sp > XB_SPIN_CAP) { atomicAdd(&bar[XB_TMO], 1u); break; } }
    }
    nloc = mine > 0u ? mine : 1u; nx = cnt > 0u ? cnt : 1u;
}
__device__ __forceinline__ void xcd_barrier(const XcdBarrier& b) {
    asm volatile("s_waitcnt vmcnt(0)" ::: "memory");
    __syncthreads();
    if (threadIdx.x == 0) {
        unsigned* bar = b.bar;
        __builtin_amdgcn_s_waitcnt(0);
        unsigned nloc = b.st[0], nx = b.st[1];
        if (nloc == 0u) { xcd_barrier_complete(bar, b.x, nloc, nx); b.st[0] = nloc; b.st[1] = nx; }
        const unsigned old = xb_add(&bar[XB_XSUB(b.x)], 1u);
        const unsigned gen = old / nloc;
        if (old + 1u == (gen + 1u) * nloc) {
            __builtin_amdgcn_fence(__ATOMIC_RELEASE, "agent");
            asm volatile("s_waitcnt vmcnt(0)" ::: "memory");
            const unsigned og = xb_add(&bar[XB_TOP], 1u);
            const unsigned tg = og / nx;
            if (og + 1u == (tg + 1u) * nx) xb_add(&bar[XB_TOPGEN], 1u);
            else XB_SPIN(xb_ld(&bar[XB_TOPGEN]) == tg, bar);
            __builtin_amdgcn_fence(__ATOMIC_ACQUIRE, "agent");
            xb_add(&bar[XB_XGEN(b.x)], 1u);
            asm volatile("s_waitcnt vmcnt(0)" ::: "memory");
        } else {
            XB_SPIN(xb_ld(&bar[XB_XGEN(b.x)]) == gen, bar);
            __builtin_amdgcn_fence(__ATOMIC_ACQUIRE, "agent");
            asm volatile("s_waitcnt vmcnt(0)" ::: "memory");
        }
    }
    __syncthreads();
}

namespace g8 {
constexpr int BM = 256, BK = 64, HALF = 128, HTB = HALF * BK * 2, NXCD = 8, WGM = 8;
__device__ __forceinline__ int lds_byte(int r, int c) { const int st = (r >> 4) * 2 + (c >> 5), rr = r & 15, cc = c & 31, ob = rr * 64 + cc * 2; return st * 1024 + (ob ^ (((ob >> 9) & 1) << 5)); }
__device__ __forceinline__ void stage_rc(int b, int& R, int& C) { const int st = b / 1024, sb = b % 1024, swz = sb ^ (((sb >> 9) & 1) << 5); R = (st >> 1) * 16 + swz / 64; C = (st & 1) * 32 + (swz % 64) / 2; }
__device__ __forceinline__ int perm32(int rho) { const int n = rho >> 4, i = rho & 15; return 8 * (i >> 2) + 4 * n + (i & 3); }

struct GUnit { int pm, pn; unsigned a, b; int x, y, kt; };

struct SchedDense {
    static constexpr bool GATHER = false, VARK = false;
    const char* A; const char* B; unsigned tsA, tsB; int nM, nN, nwg, G, c;
    __device__ __forceinline__ void init(const void* A_, const void* B_, int M, int N, int lda, int ldb, int G_, int c_) {
        A = (const char*)A_; B = (const char*)B_; nM = M / BM; nN = N / BM; nwg = nM * nN; G = G_; c = c_; tsA = (unsigned)(BM * lda * 2); tsB = (unsigned)(BM * ldb * 2); }
    __device__ __forceinline__ bool next(int i, GUnit& u) const {
        const long L = (long)i * G + c; if (L >= nwg) return false;
        int wgid = (int)L; { const int q = nwg / NXCD, r = nwg % NXCD, xcd = wgid % NXCD, off = wgid / NXCD; wgid = (xcd < r ? xcd * (q + 1) : r * (q + 1) + (xcd - r) * q) + off; }
        const int nig = WGM * nN, gid = wgid / nig, fm = gid * WGM, gsz = (nM - fm) < WGM ? (nM - fm) : WGM;
        u.pm = fm + ((wgid % nig) % gsz); u.pn = (wgid % nig) / gsz; u.a = (unsigned)u.pm * tsA; u.b = (unsigned)u.pn * tsB; u.x = 0; u.y = 0; return true;
    }
    __device__ __forceinline__ unsigned arow(const GUnit&, int) const { return 0u; }
};
struct SchedMerge {
    static constexpr bool GATHER = false, VARK = true;
    const char* A; const char* B; SchedDense D;
    __device__ __forceinline__ void init(const void* A_, const void* B_, int M, int G_, int c_) { A = (const char*)A_; B = (const char*)B_; D.init(A_, B_, M, 1024, KCAT, KCAT, G_, c_); }
    __device__ __forceinline__ bool next(int i, GUnit& u) const {
        const int tr = i / 3, j = i - 3 * tr; if (!D.next(tr, u)) return false;
        const unsigned ko = j == 0 ? 0u : (j == 1 ? 1024u : 1792u);
        u.a += ko; u.b += ko; u.x = j; u.kt = (j == 1) ? 6 : 8; return true;
    }
    __device__ __forceinline__ unsigned arow(const GUnit&, int) const { return 0u; }
};
struct SchedS5 {
    static constexpr bool GATHER = false, VARK = false;
    const char* A; const char* B; unsigned bstride; int G, c;
    __device__ __forceinline__ bool next(int i, GUnit& u) const {
        const int L = i * G + c; if (L >= 24 * 9) return false;
        const int g = L / 9, tl = L % 9; u.pm = tl; u.pn = 0; u.x = g; u.y = 0;
        u.a = (unsigned)((g * S5R + 256 * tl) * 512) * 2u; u.b = (unsigned)g * bstride; return true;
    }
    __device__ __forceinline__ unsigned arow(const GUnit&, int) const { return 0u; }
};
struct SchedMoeUp {
    static constexpr bool GATHER = true, VARK = false;
    const char* A; const char* B; const int* ltok; const LAS int* tstart; const LAS int* cnt; int G, c;
    __device__ __forceinline__ bool next(int i, GUnit& u) const {
        const int L = i * G + c; const int T = L >> 1; if (T >= tstart[64]) return false;
        int q = 0;
#pragma unroll
        for (int st = 32; st >= 1; st >>= 1) q += (tstart[q + st] <= T) ? st : 0;
        u.pm = T; u.pn = L & 1; u.x = q; u.y = T - tstart[q]; u.a = 0u; u.b = (unsigned)(((q & 31) * 512 + (L & 1) * 256) * 1024) * 2u; return true;
    }
    __device__ __forceinline__ unsigned arow(const GUnit& u, int R) const {
        const int idx = 256 * u.y + R; const int tok = idx < cnt[u.x] ? ltok[(size_t)u.x * LCAP + idx] : 0; return (unsigned)tok * 2048u; }
};
struct SchedMoeDown {
    static constexpr bool GATHER = false, VARK = false;
    const char* A; const char* B; const LAS int* tstart; int G, c;
    __device__ __forceinline__ bool next(int i, GUnit& u) const {
        const int L = i * G + c; const int T = L >> 2; if (T >= tstart[64]) return false;
        int q = 0;
#pragma unroll
        for (int st = 32; st >= 1; st >>= 1) q += (tstart[q + st] <= T) ? st : 0;
        u.pm = T; u.pn = L & 3; u.x = q; u.y = T - tstart[q]; u.a = (unsigned)(T * 256 * 256) * 2u; u.b = (unsigned)(((q & 31) * 1024 + (L & 3) * 256) * 256) * 2u; return true;
    }
    __device__ __forceinline__ unsigned arow(const GUnit&, int) const { return 0u; }
};

template <class Epi, class Sched>
__device__ __forceinline__ void gemm_run(LAS unsigned char* lds, const int K, const int lda, const int ldb, const Sched& S, const Epi& E) {
    const int tid = opq_v((int)threadIdx.x), wid = __builtin_amdgcn_readfirstlane(tid >> 6), lane = tid & 63, wr = wid >> 2, wc = wid & 3, fr = lane & 15, fq = lane >> 4;
    const int nt = K / BK;
    constexpr int NH = Sched::GATHER ? 2 : 1;
    unsigned voffB[2], vAc[NH][2];
#pragma unroll
    for (int i = 0; i < 2; ++i) { int R, C; stage_rc(tid * 16 + i * 8192, R, C); const int Rb = Epi::PERM ? ((R & ~31) + perm32(R & 31)) : R;
        voffB[i] = (unsigned)(Rb * ldb + C) * 2u; }
    constexpr unsigned kstep = BK * 2;
    const unsigned hstepB = (unsigned)(HALF * ldb * 2);
    const unsigned hstepA = Sched::GATHER ? 0u : (unsigned)(HALF * lda * 2);
    const char* const baseA = S.A; const char* const baseB = S.B;
    const unsigned ldsw = (unsigned)wid * 1024u;
    const int aoff = lds_byte(wr * 64 + fr, fq * 8), boff = lds_byte(wc * 32 + fr, fq * 8);
#define G8_SA(b, h) (((b) * 2 + (h)) * HTB)
#define G8_SB(b, h) ((4 + (b) * 2 + (h)) * HTB)
#define G8_STAGE_A(bufoff, gbase, VA, h) do { _Pragma("unroll") for (int _i = 0; _i < 2; ++_i) \
        __builtin_amdgcn_global_load_lds((const unsigned*)(baseA + ((gbase) + (h) * hstepA) + opq_u((VA)[(h) * (NH - 1)][_i])), (LAS unsigned*)(lds + (bufoff) + ldsw + _i * 8192), 16, 0, 0); } while (0)
#define G8_STAGE_B(bufoff, gbase) do { _Pragma("unroll") for (int _i = 0; _i < 2; ++_i) \
        __builtin_amdgcn_global_load_lds((const unsigned*)(baseB + (gbase) + opq_u(voffB[_i])), (LAS unsigned*)(lds + (bufoff) + ldsw + _i * 8192), 16, 0, 0); } while (0)
#define G8_LDA(dst, b, h) do { _Pragma("unroll") for (int m = 0; m < 4; ++m) _Pragma("unroll") for (int k = 0; k < 2; ++k) dst[m][k] = *(const LAS bf16x8*)(lds + G8_SA(b, h) + aoff + m * 2048 + k * 1024); } while (0)
#define G8_LDB(dst, b, h) do { _Pragma("unroll") for (int n = 0; n < 2; ++n) _Pragma("unroll") for (int k = 0; k < 2; ++k) dst[n][k] = *(const LAS bf16x8*)(lds + G8_SB(b, h) + boff + n * 2048 + k * 1024); } while (0)
#define G8_MMA(ai, bj, At, Bt) do { __builtin_amdgcn_s_setprio(1); _Pragma("unroll") for (int m = 0; m < 4; ++m) _Pragma("unroll") for (int n = 0; n < 2; ++n) _Pragma("unroll") for (int k = 0; k < 2; ++k) \
        acc[ai][bj][m][n] = __builtin_amdgcn_mfma_f32_16x16x32_bf16(Bt[n][k], At[m][k], acc[ai][bj][m][n], 0, 0, 0); __builtin_amdgcn_s_setprio(0); } while (0)
#define G8_WAIT_V(n) asm volatile("s_waitcnt vmcnt(" #n ")" ::: "memory")
#define G8_WAIT_L(n) asm volatile("s_waitcnt lgkmcnt(" #n ")" ::: "memory")
#define G8_BAR __builtin_amdgcn_s_barrier()
#define G8_SCHED __builtin_amdgcn_sched_barrier(0)
#define G8_KPAIR_A(a1) do { \
            G8_LDB(B0, 0, 0); G8_LDB(B1, 0, 1); G8_SCHED; G8_LDA(At, 0, 0); G8_STAGE_A(G8_SA(1, 1), (a1), vAc, 1); \
            G8_WAIT_V(8); G8_WAIT_L(0); G8_BAR; G8_MMA(0, 0, At, B0); G8_MMA(0, 1, At, B1); G8_BAR; G8_SCHED; } while (0)
#define G8_KPAIR_B(a2, b2, VA2) do { \
            G8_LDA(At, 0, 1); G8_STAGE_B(G8_SB(0, 0), (b2)); G8_STAGE_B(G8_SB(0, 1), (b2) + hstepB); G8_STAGE_A(G8_SA(0, 0), (a2), VA2, 0); \
            G8_WAIT_V(8); G8_WAIT_L(0); G8_BAR; G8_MMA(1, 0, At, B0); G8_MMA(1, 1, At, B1); G8_BAR; G8_SCHED; \
            G8_LDB(B0, 1, 0); G8_LDB(B1, 1, 1); G8_SCHED; G8_LDA(At, 1, 0); G8_STAGE_A(G8_SA(0, 1), (a2), VA2, 1); \
            G8_WAIT_V(8); G8_WAIT_L(0); G8_BAR; G8_MMA(0, 0, At, B0); G8_MMA(0, 1, At, B1); G8_BAR; G8_SCHED; \
            G8_LDA(At, 1, 1); G8_STAGE_B(G8_SB(1, 0), (b2) + kstep); G8_STAGE_B(G8_SB(1, 1), (b2) + kstep + hstepB); G8_STAGE_A(G8_SA(1, 0), (a2) + kstep, VA2, 0); \
            G8_WAIT_V(8); G8_WAIT_L(0); G8_BAR; G8_MMA(1, 0, At, B0); G8_MMA(1, 1, At, B1); G8_BAR; G8_SCHED; } while (0)
#define G8_KPAIR(a1, a2, b2, VA2) do { G8_KPAIR_A(a1); G8_KPAIR_B(a2, b2, VA2); } while (0)
    GUnit cur, nxt; int ui = 0;
    if (!S.next(0, cur)) return;
    f32x4 acc[2][2][4][2];
#pragma unroll
    for (int a = 0; a < 2; ++a)
#pragma unroll
        for (int b = 0; b < 2; ++b)
#pragma unroll
            for (int m = 0; m < 4; ++m)
#pragma unroll
                for (int n = 0; n < 2; ++n) acc[a][b][m][n] = (f32x4){0.f, 0.f, 0.f, 0.f};
    bf16x8 At[4][2], B0[2][2], B1[2][2];
#pragma unroll
    for (int h = 0; h < NH; ++h)
#pragma unroll
        for (int i = 0; i < 2; ++i) { int R, C; stage_rc(tid * 16 + i * 8192, R, C);
            if constexpr (Sched::GATHER) vAc[h][i] = S.arow(cur, R + HALF * h) + (unsigned)C * 2u;
            else vAc[h][i] = (unsigned)(R * lda + C) * 2u; }
    unsigned cA = cur.a, cB = cur.b;
    G8_STAGE_B(G8_SB(0, 0), cB); G8_STAGE_B(G8_SB(0, 1), cB + hstepB); G8_STAGE_A(G8_SA(0, 0), cA, vAc, 0); G8_STAGE_A(G8_SA(0, 1), cA, vAc, 1);
    if (wr == 1) G8_BAR;
    G8_WAIT_V(2); G8_BAR;
    G8_STAGE_B(G8_SB(1, 0), cB + kstep); G8_STAGE_A(G8_SA(1, 0), cA + kstep, vAc, 0); G8_STAGE_B(G8_SB(1, 1), cB + kstep + hstepB);
    G8_WAIT_V(6); G8_BAR;
    for (;;) {
        const bool has_next = S.next(ui + 1, nxt);
        const unsigned nA = has_next ? nxt.a : cA, nB = has_next ? nxt.b : cB;
        const int ntu = Sched::VARK ? cur.kt : nt;
        for (int t = 0; t < ntu - 2; t += 2) { const unsigned a1 = cA + (unsigned)(t + 1) * kstep, a2 = cA + (unsigned)(t + 2) * kstep, b2 = cB + (unsigned)(t + 2) * kstep; G8_KPAIR(a1, a2, b2, vAc); }
        {
            const unsigned a1 = cA + (unsigned)(ntu - 1) * kstep;
            if constexpr (Sched::GATHER) {
                G8_KPAIR_A(a1);
                if (has_next) {
#pragma unroll
                    for (int h = 0; h < 2; ++h)
#pragma unroll
                        for (int i = 0; i < 2; ++i) { int R, C; stage_rc(tid * 16 + i * 8192, R, C); vAc[h][i] = S.arow(nxt, R + HALF * h) + (unsigned)C * 2u; }
                }
                G8_KPAIR_B(nA, nB, vAc);
            } else {
                G8_KPAIR(a1, nA, nB, vAc);
            }
        }
        if (wr == 0) G8_BAR;
        E(acc, cur, wr, wc, opq_v(fr), opq_v(fq));
        if (!has_next) break;
        if (E.zero_after(cur)) {
#pragma unroll
        for (int a = 0; a < 2; ++a)
#pragma unroll
            for (int b = 0; b < 2; ++b)
#pragma unroll
                for (int m = 0; m < 4; ++m)
#pragma unroll
                    for (int n = 0; n < 2; ++n) acc[a][b][m][n] = (f32x4){0.f, 0.f, 0.f, 0.f};
        }
        cur = nxt; cA = nA; cB = nB; ++ui;
        if (wr == 1) G8_BAR;
    }
    G8_WAIT_V(0);
    G8_BAR;
#undef G8_SA
#undef G8_SB
#undef G8_STAGE_A
#undef G8_STAGE_B
#undef G8_LDA
#undef G8_LDB
#undef G8_MMA
#undef G8_WAIT_V
#undef G8_WAIT_L
#undef G8_BAR
#undef G8_SCHED
#undef G8_KPAIR
#undef G8_KPAIR_A
#undef G8_KPAIR_B
}

typedef f32x4 Acc[2][2][4][2];

__device__ __forceinline__ u32x4 pack8(const f32x4 v0, const f32x4 v1) { u32x4 w; w.x = cvt_pk_bf16(v0[0], v0[1]); w.y = cvt_pk_bf16(v0[2], v0[3]); w.z = cvt_pk_bf16(v1[0], v1[1]); w.w = cvt_pk_bf16(v1[2], v1[3]); return w; }

struct EpiWin {
    static constexpr bool PERM = true; __device__ __forceinline__ bool zero_after(const GUnit&) const { return true; }
    unsigned char* wsb; LAS unsigned char* tsc;
    __device__ __forceinline__ void operator()(Acc& acc, const GUnit& u, int wr, int wc, int fr, int fq) const {
        bf16_t* const uvg = (bf16_t*)(wsb + WS_UVG); bf16_t* const qk = (bf16_t*)(wsb + WS_QK); bf16_t* const vt = (bf16_t*)(wsb + WS_VT); bf16_t* const vtc = (bf16_t*)(wsb + WS_VT + 32 * MiB);
        unsigned char* const gates = wsb + WS_G; bf16_t* const s5a = (bf16_t*)(wsb + WS_S5A); const float* const ropec = (const float*)(wsb + WS_ROPE); const float* const ropes = ropec + 128 * 16;
        const int pn = u.pn, row0 = u.pm * 256 + wr * 64 + fr, cl = wc * 32 + 8 * fq;
        if (pn < 4) {
#pragma unroll
            for (int ai = 0; ai < 2; ++ai)
#pragma unroll
                for (int m = 0; m < 4; ++m) { bf16_t* rp = uvg + (size_t)(row0 + ai * 128 + m * 16) * 1024 + pn * 256 + cl;
#pragma unroll
                    for (int bj = 0; bj < 2; ++bj) { f32x4 v0 = acc[ai][bj][m][0], v1 = acc[ai][bj][m][1];
#pragma unroll
                        for (int j = 0; j < 4; ++j) { v0[j] = gelu_tanh(v0[j]); v1[j] = gelu_tanh(v1[j]); }
                        *(u32x4*)(rp + bj * 128) = pack8(v0, v1); } }
        } else if (pn < 8) {
            const float sc = pn < 6 ? 0.125f * 1.4426950408889634f : 1.0f;   const bool lat = u.pm < 128; const int seg = wc & 1, f0 = 8 * (fq & 1); const float sg = fq < 2 ? -1.f : 1.f;
#pragma unroll
            for (int ai = 0; ai < 2; ++ai) { const int grow = (4 * u.pm + 2 * ai + wr) & 127;
#pragma unroll
                for (int m = 0; m < 4; ++m) { bf16_t* rp = qk + (size_t)(row0 + ai * 128 + m * 16) * 1024 + (pn - 4) * 256 + cl;
                    const int pos = seg ? (16 * m + fr) : grow;
                    f32x4 c0 = {1.f, 1.f, 1.f, 1.f}, c1 = c0, s0 = {0.f, 0.f, 0.f, 0.f}, s1 = s0;
                    if (lat) { c0 = *(const f32x4*)(ropec + pos * 16 + f0); c1 = *(const f32x4*)(ropec + pos * 16 + f0 + 4); s0 = *(const f32x4*)(ropes + pos * 16 + f0); s1 = *(const f32x4*)(ropes + pos * 16 + f0 + 4); }
#pragma unroll
                    for (int bj = 0; bj < 2; ++bj) { f32x4 v0 = acc[ai][bj][m][0], v1 = acc[ai][bj][m][1], o0, o1;
#pragma unroll
                        for (int j = 0; j < 4; ++j) { const float x0 = shx<32>(v0[j], fr + 16 * fq), x1 = shx<32>(v1[j], fr + 16 * fq);
                            o0[j] = (v0[j] * c0[j] + sg * x0 * s0[j]) * sc; o1[j] = (v1[j] * c1[j] + sg * x1 * s1[j]) * sc; }
                        *(u32x4*)(rp + bj * 128) = pack8(o0, o1); } } }
        } else if (pn < 10) {
            LAS bf16_t* tb = (LAS bf16_t*)(tsc + (wr * 4 + wc) * 2048); const int lane_ = fr + 16 * fq, tcol = lane_ >> 1, thalf = lane_ & 1;
            int it_ = 0;
#pragma unroll
            for (int ai = 0; ai < 2; ++ai)
#pragma unroll
                for (int m = 0; m < 4; ++m) { const int rowb = u.pm * 256 + wr * 64 + ai * 128 + m * 16;
                    bf16_t* bp; size_t stride;
                    if (rowb < NLAT) { bp = vt + (size_t)((rowb >> 13) * 512) * 8192 + (rowb & 8191); stride = 8192; }
                    else { const int rr = rowb - NLAT; bp = vtc + (size_t)((rr >> 8) * 512) * 256 + (rr & 255); stride = 256; }
#pragma unroll
                    for (int bj = 0; bj < 2; ++bj, ++it_) { LAS bf16_t* t = tb + (it_ & 1) * 512;
#pragma unroll
                        for (int n = 0; n < 2; ++n)
#pragma unroll
                            for (int j = 0; j < 4; ++j) t[(8 * fq + 4 * n + j) * 16 + fr] = (bf16_t)f2bf(acc[ai][bj][m][n][j]);
                        asm volatile("s_waitcnt lgkmcnt(0)" ::: "memory");
                        const u32x4 v = *(const LAS u32x4*)(t + tcol * 16 + thalf * 8);
                        const int c = (pn - 8) * 256 + bj * 128 + wc * 32 + tcol;
                        *(u32x4*)(bp + (size_t)c * stride + thalf * 8) = v; } }
        } else if (pn < 22) {
#pragma unroll
            for (int ai = 0; ai < 2; ++ai)
#pragma unroll
                for (int m = 0; m < 4; ++m) { unsigned char* rp = gates + (size_t)(row0 + ai * 128 + m * 16) * 3072 + (pn - 10) * 256 + cl;
#pragma unroll
                    for (int bj = 0; bj < 2; ++bj) { u32x2 w;
#pragma unroll
                        for (int n = 0; n < 2; ++n) { unsigned pk = 0;
#pragma unroll
                            for (int j = 0; j < 4; ++j) { const float e = __builtin_amdgcn_exp2f(acc[ai][bj][m][n][j] * -1.4426950408889634f);
                                const float q = fmaxf(__builtin_amdgcn_rcpf(__builtin_fmaf(e, 1.0f / 255.0f, 1.0f / 255.0f)), 1.0f); pk = __builtin_amdgcn_cvt_pk_u8_f32(q, j, pk); }
                            w[n] = pk; }
                        *(u32x2*)(rp + bj * 128) = w; } }
        } else {
#pragma unroll
            for (int bj = 0; bj < 2; ++bj) { const int ch = (pn - 22) * 256 + bj * 128 + cl;
                if (ch < 384) { const int g = ch >> 4, c0 = ch & 15;
#pragma unroll
                    for (int ai = 0; ai < 2; ++ai)
#pragma unroll
                        for (int m = 0; m < 4; ++m) { const int row = row0 + ai * 128 + m * 16;
                            *(u32x4*)(s5a + ((size_t)(g * S5R + (row >> 4)) * 512) + (row & 15) * 16 + c0) = pack8(acc[ai][bj][m][0], acc[ai][bj][m][1]); } } }
        }
    }
};

struct EpiMerge {
    static constexpr bool PERM = true;
    const unsigned char* gates; bf16_t* mb;
    __device__ __forceinline__ bool zero_after(const GUnit& u) const { return u.x == 2; }
    __device__ __forceinline__ void operator()(Acc& acc, const GUnit& u, int wr, int wc, int fr, int fq) const {
        const int row0 = u.pm * 256 + wr * 64 + fr, col = u.pn * 256 + wc * 32 + 8 * fq; const int j = u.x;
        if (j < 2) {
#pragma unroll
            for (int ai = 0; ai < 2; ++ai)
#pragma unroll
                for (int m = 0; m < 4; ++m) { const unsigned char* rp = gates + (size_t)(row0 + ai * 128 + m * 16) * 3072 + 1024 * j + col;
#pragma unroll
                    for (int bj = 0; bj < 2; ++bj) { const u32x2 ga = *(const u32x2*)(rp + bj * 128), gb = *(const u32x2*)(rp + bj * 128 + 1024);
#pragma unroll
                        for (int n = 0; n < 2; ++n)
#pragma unroll
                            for (int k = 0; k < 4; ++k) { const float a = (float)((ga[n] >> (8 * k)) & 255u), b = (float)((gb[n] >> (8 * k)) & 255u);
                                acc[ai][bj][m][n][k] *= a * __builtin_amdgcn_rcpf(b); } }
                    if (m == 3) asm volatile("" ::: "memory"); }
        } else {
#pragma unroll
            for (int ai = 0; ai < 2; ++ai)
#pragma unroll
                for (int m = 0; m < 4; ++m) { const size_t row = (size_t)(row0 + ai * 128 + m * 16); const unsigned char* rp = gates + row * 3072 + 2048 + col;
#pragma unroll
                    for (int bj = 0; bj < 2; ++bj) { const u32x2 gc = *(const u32x2*)(rp + bj * 128); f32x4 v0, v1;
#pragma unroll
                        for (int k = 0; k < 4; ++k) { v0[k] = acc[ai][bj][m][0][k] * ((float)((gc[0] >> (8 * k)) & 255u) * (1.0f / 255.0f)); v1[k] = acc[ai][bj][m][1][k] * ((float)((gc[1] >> (8 * k)) & 255u) * (1.0f / 255.0f)); }
                        *(u32x4*)(mb + row * 1024 + col + bj * 128) = pack8(v0, v1); }
                    if (m & 1) asm volatile("" ::: "memory"); }
        }
    }
};

struct EpiWout {
    static constexpr bool PERM = false; __device__ __forceinline__ bool zero_after(const GUnit&) const { return true; }
    const float* old_lat; const float* old_ctx; float* new_lat; float* new_ctx; const float* modl; float sc;
    __device__ __forceinline__ void operator()(Acc& acc, const GUnit& u, int wr, int wc, int fr, int fq) const {
        const bool lat = u.pm < 128; const int mrow = lat ? (u.pm >> 5) : 4;
        const float* gp = modl + mrow * 6144 + 2048; const int col0 = u.pn * 256 + wc * 32 + 4 * fq;
        const int rbase = (lat ? u.pm * 256 : (u.pm - 128) * 256) + wr * 64 + fr;
        const float* op = lat ? old_lat : old_ctx; float* np = lat ? new_lat : new_ctx;
        f32x4 gv[2][2];
#pragma unroll
        for (int bj = 0; bj < 2; ++bj)
#pragma unroll
            for (int n = 0; n < 2; ++n) gv[bj][n] = *(const f32x4*)(gp + col0 + bj * 128 + n * 16) * sc;
#pragma unroll
        for (int ai = 0; ai < 2; ++ai) { f32x4 xo[4][2][2];
#pragma unroll
            for (int m = 0; m < 4; ++m) { const size_t off = (size_t)(rbase + ai * 128 + m * 16) * 1024 + col0;
#pragma unroll
                for (int bj = 0; bj < 2; ++bj)
#pragma unroll
                    for (int n = 0; n < 2; ++n) xo[m][bj][n] = *(const f32x4*)(op + off + bj * 128 + n * 16); }
#pragma unroll
            for (int m = 0; m < 4; ++m) { const size_t off = (size_t)(rbase + ai * 128 + m * 16) * 1024 + col0;
#pragma unroll
                for (int bj = 0; bj < 2; ++bj)
#pragma unroll
                    for (int n = 0; n < 2; ++n) *(f32x4*)(np + off + bj * 128 + n * 16) = xo[m][bj][n] + gv[bj][n] * acc[ai][bj][m][n]; }
            asm volatile("" ::: "memory"); }
    }
};

struct EpiLogits {
    static constexpr bool PERM = false; __device__ __forceinline__ bool zero_after(const GUnit&) const { return true; }
    float* lg;
    __device__ __forceinline__ void operator()(Acc& acc, const GUnit& u, int wr, int wc, int fr, int fq) const {
        const int row0 = u.pm * 256 + wr * 64 + fr, col0 = wc * 32 + 4 * fq;
#pragma unroll
        for (int ai = 0; ai < 2; ++ai)
#pragma unroll
            for (int m = 0; m < 4; ++m) { float* rp = lg + (size_t)(row0 + ai * 128 + m * 16) * 128 + col0;
#pragma unroll
                for (int n = 0; n < 2; ++n) *(f32x4*)(rp + n * 16) = acc[ai][0][m][n]; }
    }
};

struct EpiS5E {
    static constexpr bool PERM = true; __device__ __forceinline__ bool zero_after(const GUnit&) const { return true; }
    bf16_t* e;
    __device__ __forceinline__ void operator()(Acc& acc, const GUnit& u, int wr, int wc, int fr, int fq) const {
        const int R0 = u.pm * 256 + wr * 64 + fr, cl = wc * 32 + 8 * fq;
#pragma unroll
        for (int ai = 0; ai < 2; ++ai)
#pragma unroll
            for (int m = 0; m < 4; ++m) { bf16_t* rp = e + ((size_t)(u.x * S5R + R0 + ai * 128 + m * 16) * 256) + cl;
#pragma unroll
                for (int bj = 0; bj < 2; ++bj) *(u32x4*)(rp + bj * 128) = pack8(acc[ai][bj][m][0], acc[ai][bj][m][1]); }
    }
};

struct EpiS5Y {
    static constexpr bool PERM = true; __device__ __forceinline__ bool zero_after(const GUnit&) const { return true; }
    bf16_t* yg;
    __device__ __forceinline__ void operator()(Acc& acc, const GUnit& u, int wr, int wc, int fr, int fq) const {
        const int R0 = u.pm * 256 + wr * 64 + fr, cl = wc * 32 + 8 * fq;
#pragma unroll
        for (int ai = 0; ai < 2; ++ai)
#pragma unroll
            for (int m = 0; m < 4; ++m) { const int R = R0 + ai * 128 + m * 16;
                if (R < S5RV) {
#pragma unroll
                    for (int bj = 0; bj < 2; ++bj) { const int col8 = bj * 128 + cl, i = col8 >> 4, co0 = col8 & 15; f32x4 v0 = acc[ai][bj][m][0], v1 = acc[ai][bj][m][1];
#pragma unroll
                        for (int j = 0; j < 4; ++j) { v0[j] = gelu_tanh(v0[j]); v1[j] = gelu_tanh(v1[j]); }
                        *(u32x4*)(yg + (size_t)(16 * R + i) * 384 + 16 * u.x + co0) = pack8(v0, v1); } } }
    }
};

struct EpiGlu {
    static constexpr bool PERM = true; __device__ __forceinline__ bool zero_after(const GUnit&) const { return true; }
    const bf16_t* yg; bf16_t* ycat;
    __device__ __forceinline__ void operator()(Acc& acc, const GUnit& u, int wr, int wc, int fr, int fq) const {
        const int row0 = u.pm * 256 + wr * 64 + fr, col0 = u.pn * 256 + wc * 32 + 8 * fq;
#pragma unroll
        for (int ai = 0; ai < 2; ++ai)
#pragma unroll
            for (int m = 0; m < 4; ++m) { const size_t row = (size_t)(row0 + ai * 128 + m * 16);
#pragma unroll
                for (int bj = 0; bj < 2; ++bj) {
                    if (u.pn == 0 || bj == 0) { const int col = col0 + bj * 128;
                        const u32x4 y = *(const u32x4*)(yg + row * 384 + col); f32x4 v0, v1;
#pragma unroll
                        for (int j = 0; j < 2; ++j) { v0[2 * j] = bf2f(y[j] & 0xffffu) * sigmoidf_(acc[ai][bj][m][0][2 * j]); v0[2 * j + 1] = bf2f(y[j] >> 16) * sigmoidf_(acc[ai][bj][m][0][2 * j + 1]);
                            v1[2 * j] = bf2f(y[2 + j] & 0xffffu) * sigmoidf_(acc[ai][bj][m][1][2 * j]); v1[2 * j + 1] = bf2f(y[2 + j] >> 16) * sigmoidf_(acc[ai][bj][m][1][2 * j + 1]); }
                        *(u32x4*)(ycat + row * KCAT + 512 + col) = pack8(v0, v1); } }
                asm volatile("" ::: "memory"); }
    }
};

struct EpiMoeUp {
    static constexpr bool PERM = true; __device__ __forceinline__ bool zero_after(const GUnit&) const { return true; }
    bf16_t* hid; const float* lw; const LAS int* cnt;
    __device__ __forceinline__ void operator()(Acc& acc, const GUnit& u, int wr, int wc, int fr, int fq) const {
        const int rit0 = wr * 64 + fr, cl = wc * 32 + 8 * fq; const int n_l = cnt[u.x];
#pragma unroll
        for (int ai = 0; ai < 2; ++ai)
#pragma unroll
            for (int m = 0; m < 4; ++m) { const int rit = rit0 + ai * 128 + m * 16, idx = 256 * u.y + rit;
                const float cw = idx < n_l ? lw[(size_t)u.x * LCAP + idx] : 0.f; f32x4 v0, v1;
#pragma unroll
                for (int j = 0; j < 4; ++j) { const float g0 = acc[ai][0][m][0][j], g1 = acc[ai][0][m][1][j];
                    v0[j] = g0 * sigmoidf_(g0) * acc[ai][1][m][0][j] * cw; v1[j] = g1 * sigmoidf_(g1) * acc[ai][1][m][1][j] * cw; }
                *(u32x4*)(hid + ((size_t)(256 * u.pm + rit) * 256) + 128 * u.pn + cl) = pack8(v0, v1); }
    }
};

struct EpiMoeDown {
    static constexpr bool PERM = true; __device__ __forceinline__ bool zero_after(const GUnit&) const { return true; }
    bf16_t* y0; bf16_t* y1; const int* ltok; const LAS int* cnt;
    __device__ __forceinline__ void operator()(Acc& acc, const GUnit& u, int wr, int wc, int fr, int fq) const {
        const int rit0 = wr * 64 + fr, col0 = u.pn * 256 + wc * 32 + 8 * fq; const int n_l = cnt[u.x]; bf16_t* y = u.x < 32 ? y0 : y1;
        int tk[2][4];
#pragma unroll
        for (int ai = 0; ai < 2; ++ai)
#pragma unroll
            for (int m = 0; m < 4; ++m) { const int idx = 256 * u.y + rit0 + ai * 128 + m * 16; tk[ai][m] = idx < n_l ? ltok[(size_t)u.x * LCAP + idx] : -1; }
#pragma unroll
        for (int ai = 0; ai < 2; ++ai)
#pragma unroll
            for (int m = 0; m < 4; ++m) { const int tok = tk[ai][m];
                if (tok >= 0) { bf16_t* yp = y + (size_t)tok * 1024 + col0;
#pragma unroll
                    for (int bj = 0; bj < 2; ++bj) *(u32x4*)(yp + bj * 128) = pack8(acc[ai][bj][m][0], acc[ai][bj][m][1]); } }
    }
};
}

struct Params { const float* in[34]; float* out; unsigned char* ws; };

__device__ __forceinline__ void tr_item(const float* src, int ldsrc, int ksrc0, int nsrc0, bf16_t* dst, int lddst, int ndst0, int kdst0, LAS float* scr, int lane) {
    { const int kr_ = lane >> 3, nq = (lane & 7) * 4; f32x4 t[8];
#pragma unroll
      for (int i = 0; i < 8; ++i) t[i] = src ? *(const f32x4*)(src + (size_t)(ksrc0 + 8 * i + kr_) * ldsrc + nsrc0 + nq) : (f32x4){0.f, 0.f, 0.f, 0.f};
#pragma unroll
      for (int i = 0; i < 8; ++i) { LAS float* d = scr + (8 * i + kr_) * 33 + nq; d[0] = t[i].x; d[1] = t[i].y; d[2] = t[i].z; d[3] = t[i].w; } }
    LDS_WAIT(); asm volatile("" ::: "memory");
    const int c = lane & 7;
#pragma unroll
    for (int j = 0; j < 4; ++j) { const int n = (lane >> 3) + 8 * j; const LAS float* s = scr + (8 * c) * 33 + n;
        u32x4 o; o.x = f2bf(s[0]) | (f2bf(s[33]) << 16); o.y = f2bf(s[66]) | (f2bf(s[99]) << 16); o.z = f2bf(s[132]) | (f2bf(s[165]) << 16); o.w = f2bf(s[198]) | (f2bf(s[231]) << 16);
        *(u32x4*)(dst + (size_t)(ndst0 + n) * lddst + kdst0 + 8 * c) = o; }
    LDS_WAIT(); asm volatile("" ::: "memory");
}

__device__ __forceinline__ void norm_mod_row(const float* xrow, const float* gain, const float* shift, const float* scale, bf16_t* orow, int lane, const bf16_t* yrow = nullptr, float* xwb = nullptr) {
    const f32x4* xr = (const f32x4*)xrow + lane; f32x4 v[4]; float s = 0.f;
#pragma unroll
    for (int j = 0; j < 4; ++j) { v[j] = xr[64 * j];
        if (yrow) { const u32x2 yy = *(const u32x2*)(yrow + 4 * lane + 256 * j); v[j].x += bf2f(yy.x & 0xffffu); v[j].y += bf2f(yy.x >> 16); v[j].z += bf2f(yy.y & 0xffffu); v[j].w += bf2f(yy.y >> 16); ((f32x4*)xwb + lane)[64 * j] = v[j]; }
        s += (v[j].x * v[j].x + v[j].y * v[j].y) + (v[j].z * v[j].z + v[j].w * v[j].w); }
    const float r = 1.0f / sqrtf(wave_sum(s, lane) * (1.0f / DM) + EPSN);
#pragma unroll
    for (int j = 0; j < 4; ++j) { const int c = 4 * lane + 256 * j; const f32x4 g = *(const f32x4*)(gain + c), sh = *(const f32x4*)(shift + c), sc = *(const f32x4*)(scale + c);
        const f32x4 h = (v[j] * r * g) * (sc + 1.0f) + sh;
        u32x2 o; o.x = cvt_pk_bf16(h.x, h.y); o.y = cvt_pk_bf16(h.z, h.w); *(u32x2*)(orow + c) = o; }
}

__device__ __forceinline__ void norm_mod_row2(const float* xa, const float* xb, const float* gain, const float* sha, const float* sca, const float* shb, const float* scb, bf16_t* oa, bf16_t* ob, int lane, const bf16_t* ya, const bf16_t* yb, const float* ga = nullptr, const float* gb = nullptr, const bf16_t* za = nullptr, const bf16_t* zb = nullptr) {
    const f32x4* pa = (const f32x4*)xa + lane; const f32x4* pb = (const f32x4*)xb + lane; f32x4 va[4], vb[4]; u32x2 qa[4], qb[4], ra_[4], rb_[4]; float s0 = 0.f, s1 = 0.f;
#pragma unroll
    for (int j = 0; j < 4; ++j) { va[j] = pa[64 * j]; vb[j] = pb[64 * j]; if (ya) { qa[j] = *(const u32x2*)(ya + 4 * lane + 256 * j); qb[j] = *(const u32x2*)(yb + 4 * lane + 256 * j); ra_[j] = *(const u32x2*)(za + 4 * lane + 256 * j); rb_[j] = *(const u32x2*)(zb + 4 * lane + 256 * j); } }
#pragma unroll
    for (int j = 0; j < 4; ++j) {
        if (ya) { const f32x4 g2a = *(const f32x4*)(ga + 4 * lane + 256 * j), g2b = *(const f32x4*)(gb + 4 * lane + 256 * j);
                  va[j].x += g2a.x * (bf2f(qa[j].x & 0xffffu) + bf2f(ra_[j].x & 0xffffu)); va[j].y += g2a.y * (bf2f(qa[j].x >> 16) + bf2f(ra_[j].x >> 16)); va[j].z += g2a.z * (bf2f(qa[j].y & 0xffffu) + bf2f(ra_[j].y & 0xffffu)); va[j].w += g2a.w * (bf2f(qa[j].y >> 16) + bf2f(ra_[j].y >> 16));
                  vb[j].x += g2b.x * (bf2f(qb[j].x & 0xffffu) + bf2f(rb_[j].x & 0xffffu)); vb[j].y += g2b.y * (bf2f(qb[j].x >> 16) + bf2f(rb_[j].x >> 16)); vb[j].z += g2b.z * (bf2f(qb[j].y & 0xffffu) + bf2f(rb_[j].y & 0xffffu)); vb[j].w += g2b.w * (bf2f(qb[j].y >> 16) + bf2f(rb_[j].y >> 16));
                  ((f32x4*)xa + lane)[64 * j] = va[j]; ((f32x4*)xb + lane)[64 * j] = vb[j]; }
        s0 += (va[j].x * va[j].x + va[j].y * va[j].y) + (va[j].z * va[j].z + va[j].w * va[j].w); s1 += (vb[j].x * vb[j].x + vb[j].y * vb[j].y) + (vb[j].z * vb[j].z + vb[j].w * vb[j].w); }
    const float ra = 1.0f / sqrtf(wave_sum(s0, lane) * (1.0f / DM) + EPSN), rb = 1.0f / sqrtf(wave_sum(s1, lane) * (1.0f / DM) + EPSN);
#pragma unroll
    for (int j = 0; j < 4; ++j) { const int c = 4 * lane + 256 * j; const f32x4 g = *(const f32x4*)(gain + c);
        { const f32x4 sh = *(const f32x4*)(sha + c), sc = *(const f32x4*)(sca + c); const f32x4 h = (va[j] * ra * g) * (sc + 1.0f) + sh; u32x2 o; o.x = cvt_pk_bf16(h.x, h.y); o.y = cvt_pk_bf16(h.z, h.w); *(u32x2*)(oa + c) = o; }
        { const f32x4 sh = *(const f32x4*)(shb + c), sc = *(const f32x4*)(scb + c); const f32x4 h = (vb[j] * rb * g) * (sc + 1.0f) + sh; u32x2 o; o.x = cvt_pk_bf16(h.x, h.y); o.y = cvt_pk_bf16(h.z, h.w); *(u32x2*)(ob + c) = o; } }
}

template <bool LATENT>
__device__ __forceinline__ void attn_tile(const bf16_t* qk, const bf16_t* vt, const bf16_t* vtc, bf16_t* ycat, const LAS float* rpbh, int b, int h, int qrow0, int r, int wt, int lane) {
    const int qi = lane & 15, g = lane >> 4;
    const bf16_t* qp = qk + (size_t)(qrow0 + qi) * 1024 + h * 64 + 8 * g;
    const bf16x8 qf0 = *(const bf16x8*)qp, qf1 = *(const bf16x8*)(qp + 32);
    float m_run = -1e30f, l_run = 0.f; f32x4 o[4];
#pragma unroll
    for (int d = 0; d < 4; ++d) o[d] = (f32x4){0.f, 0.f, 0.f, 0.f};
    const f32x4 z4 = {0.f, 0.f, 0.f, 0.f};
#define ATT_STEP(S0, S1, VB, VSTRIDE) do { \
        float cm = fmaxf(fmaxf(fmaxf(S0[0], S0[1]), fmaxf(S0[2], S0[3])), fmaxf(fmaxf(S1[0], S1[1]), fmaxf(S1[2], S1[3]))); \
        cm = fmaxf(cm, shx<16>(cm, lane)); cm = fmaxf(cm, shx<32>(cm, lane)); \
        const float mn = fmaxf(m_run, cm), al = __builtin_amdgcn_exp2f(m_run - mn); m_run = mn; \
        f32x4 p0, p1; float ps = 0.f; \
        _Pragma("unroll") for (int j = 0; j < 4; ++j) { p0[j] = __builtin_amdgcn_exp2f(S0[j] - mn); p1[j] = __builtin_amdgcn_exp2f(S1[j] - mn); ps += p0[j] + p1[j]; } \
        l_run = l_run * al + ps; \
        union { u32x4 u; bf16x8 v; } pb; pb.u = g8::pack8(p0, p1); \
        _Pragma("unroll") for (int db = 0; db < 4; ++db) { const bf16_t* vp = (VB) + (size_t)(16 * db + qi) * (VSTRIDE); \
            union { u32x4 u; bf16x8 v; } va; const u32x2 lo = *(const u32x2*)vp, hi = *(const u32x2*)(vp + 16); va.u.x = lo.x; va.u.y = lo.y; va.u.z = hi.x; va.u.w = hi.y; \
            o[db] = o[db] * al; o[db] = __builtin_amdgcn_mfma_f32_16x16x32_bf16(va.v, pb.v, o[db], 0, 0, 0); } } while (0)
    if (LATENT) {
        const int kr0 = min(max(r - 4, 0), 120); const int c0 = (wt == 0) ? 0 : (wt == 1 ? 8 : (wt == 2 ? 24 : 32));
        const int wq = 16 * wt + qi, cs = min(max(wq - 8, 0), 48);
#pragma unroll 2
        for (int jr = 0; jr < 8; ++jr) {
            const int kr = kr0 + jr, s0 = kr * 64 + c0;
            const bf16_t* kp = qk + (size_t)(b * 8192 + s0 + qi) * 1024 + 512 + h * 64 + 8 * g;
            const bf16x8 k00 = *(const bf16x8*)kp, k01 = *(const bf16x8*)(kp + 32), k10 = *(const bf16x8*)(kp + 16 * 1024), k11 = *(const bf16x8*)(kp + 16 * 1024 + 32);
            f32x4 sa = __builtin_amdgcn_mfma_f32_16x16x32_bf16(k00, qf0, z4, 0, 0, 0); sa = __builtin_amdgcn_mfma_f32_16x16x32_bf16(k01, qf1, sa, 0, 0, 0);
            f32x4 sb = __builtin_amdgcn_mfma_f32_16x16x32_bf16(k10, qf0, z4, 0, 0, 0); sb = __builtin_amdgcn_mfma_f32_16x16x32_bf16(k11, qf1, sb, 0, 0, 0);
            const LAS float* bp = rpbh + (kr - r + 7) * 31;
#pragma unroll
            for (int j = 0; j < 4; ++j) { const int wk = c0 + 4 * g + j; const int wk2 = wk + 16;
                const bool v0 = (wk >= cs) && (wk < cs + 16), v1 = (wk2 >= cs) && (wk2 < cs + 16);
                const int i0 = min(max(wk - wq + 15, 0), 30), i1 = min(max(wk2 - wq + 15, 0), 30);
                sa[j] = v0 ? sa[j] + bp[i0] : -1e30f; sb[j] = v1 ? sb[j] + bp[i1] : -1e30f; }
            const bf16_t* vb = vt + (size_t)((b * 8 + h) * 64) * 8192 + s0 + 4 * g;
            ATT_STEP(sa, sb, vb, 8192);
        }
    }
#pragma unroll 2
    for (int ch = 0; ch < 8; ++ch) {
        const int j0 = 32 * ch;
        const bf16_t* kp = qk + (size_t)(NLAT + b * 256 + j0 + qi) * 1024 + 512 + h * 64 + 8 * g;
        const bf16x8 k00 = *(const bf16x8*)kp, k01 = *(const bf16x8*)(kp + 32), k10 = *(const bf16x8*)(kp + 16 * 1024), k11 = *(const bf16x8*)(kp + 16 * 1024 + 32);
        f32x4 sa = __builtin_amdgcn_mfma_f32_16x16x32_bf16(k00, qf0, z4, 0, 0, 0); sa = __builtin_amdgcn_mfma_f32_16x16x32_bf16(k01, qf1, sa, 0, 0, 0);
        f32x4 sb = __builtin_amdgcn_mfma_f32_16x16x32_bf16(k10, qf0, z4, 0, 0, 0); sb = __builtin_amdgcn_mfma_f32_16x16x32_bf16(k11, qf1, sb, 0, 0, 0);
        const bf16_t* vb = vtc + (size_t)((b * 8 + h) * 64) * 256 + j0 + 4 * g;
        ATT_STEP(sa, sb, vb, 256);
    }
#undef ATT_STEP
    float l = l_run; l += shx<16>(l, lane); l += shx<32>(l, lane);
    const float inv = 1.0f / l;
    bf16_t* op = ycat + (size_t)(qrow0 + qi) * KCAT + 896 + h * 64 + 4 * g;
#pragma unroll
    for (int db = 0; db < 4; ++db) { u32x2 w; w.x = cvt_pk_bf16(o[db][0] * inv, o[db][1] * inv); w.y = cvt_pk_bf16(o[db][2] * inv, o[db][3] * inv); *(u32x2*)(op + 16 * db) = w; }
}

constexpr int ATT_RING = 16384, ATT_SB = 32768, ATT_NST = 15, ATT_NU = 512;
__device__ __forceinline__ void attn_lat_issue(LAS unsigned char* lds, const bf16_t* qk, const bf16_t* vt, const bf16_t* vtc, int T, int nT, int G, int bid, int wave, int lane) {
    const int Tc = T < nT ? T : nT - 1;
    const int ui = Tc / ATT_NST, s = Tc - ui * ATT_NST; const int u = bid + G * ui; const int hp = u & 3, r4 = (u >> 2) & 31, b = u >> 7;
    const int kr = min(min(max(4 * r4 - 4, 0), 120) + s, 127);
    LAS unsigned char* slot = lds + ATT_RING + (T & 3) * ATT_SB;
#pragma unroll
    for (int j = 0; j < 4; ++j) {
        const int c = (j * 8 + wave) * 64 + lane;
        const int cc = c & 1023, head = cc >> 9, row = (cc >> 3) & 63, lg = (cc & 7) ^ (row & 7), hh = 2 * hp + head;
        const bf16_t* gp;
        if (j < 2) { const int tok = (s < 11) ? (b * 8192 + kr * 64 + row) : (NLAT + b * 256 + 64 * (s - 11) + row); gp = qk + (size_t)tok * 1024 + 512 + hh * 64 + lg * 8; }
        else { gp = (s < 11) ? (vt + (size_t)((b * 8 + hh) * 64 + row) * 8192 + kr * 64 + lg * 8) : (vtc + (size_t)((b * 8 + hh) * 64 + row) * 256 + 64 * (s - 11) + lg * 8); }
        __builtin_amdgcn_global_load_lds((const unsigned*)gp, (LAS unsigned*)(slot + (j * 8 + wave) * 1024), 16, 0, 0);
    }
}
__device__ __forceinline__ void attn_lat_phase(LAS unsigned char* lds, const bf16_t* qk, const bf16_t* vt, const bf16_t* vtc, bf16_t* ycat, const LAS float* rpbS, int G, int bid, int wave, int lane) {
    const int nunits = (ATT_NU - bid + G - 1) / G; if (nunits <= 0) return;
    const int nT = nunits * ATT_NST;
    const int qi = lane & 15, g = lane >> 4, hl = wave >> 2, wt = wave & 3;
    const int c0 = (wt == 0) ? 0 : (wt == 1 ? 8 : (wt == 2 ? 24 : 32));
    const int wq = 16 * wt + qi, cs = min(max(wq - 8, 0), 48);
    float vm0[4], vm1[4];
#pragma unroll
    for (int j = 0; j < 4; ++j) { const int wk = c0 + 4 * g + j, wk2 = wk + 16; vm0[j] = ((wk >= cs) && (wk < cs + 16)) ? 0.f : -1e30f; vm1[j] = ((wk2 >= cs) && (wk2 < cs + 16)) ? 0.f : -1e30f; }
    const int boff = c0 + 4 * g - wq + 15;
    attn_lat_issue(lds, qk, vt, vtc, 0, nT, G, bid, wave, lane); attn_lat_issue(lds, qk, vt, vtc, 1, nT, G, bid, wave, lane); attn_lat_issue(lds, qk, vt, vtc, 2, nT, G, bid, wave, lane);
    int T = 0;
    const f32x4 z4 = {0.f, 0.f, 0.f, 0.f};
    for (int ui = 0; ui < nunits; ++ui) {
        const int u = bid + G * ui; const int hp = u & 3, r4 = (u >> 2) & 31, b = u >> 7; const int h = 2 * hp + hl;
        const int kstart = min(max(4 * r4 - 4, 0), 120); const int qrow = b * 8192 + (4 * r4) * 64 + 16 * wt + qi;
        bf16x8 qf[4][2]; float m_run[4], l_run[4]; f32x4 o[4][4];
#pragma unroll
        for (int i = 0; i < 4; ++i) { const bf16_t* qp = qk + (size_t)(qrow + 64 * i) * 1024 + h * 64 + 8 * g; qf[i][0] = *(const bf16x8*)qp; qf[i][1] = *(const bf16x8*)(qp + 32); m_run[i] = -1e30f; l_run[i] = 0.f;
#pragma unroll
            for (int d = 0; d < 4; ++d) o[i][d] = z4; }
        const LAS float* rpbh = rpbS + h * 465;
#pragma unroll 1
        for (int s = 0; s < ATT_NST; ++s, ++T) {
            asm volatile("s_waitcnt vmcnt(8)" ::: "memory");
            __builtin_amdgcn_s_barrier();
            asm volatile("" ::: "memory");
            attn_lat_issue(lds, qk, vt, vtc, T + 3, nT, G, bid, wave, lane);
            const LAS unsigned char* Kb = lds + ATT_RING + (T & 3) * ATT_SB + hl * 8192; const LAS unsigned char* Vb = Kb + 16384;
            const bool lat = s < 11; const int kr = kstart + s; const int nsub = lat ? 1 : 2;
            for (int ss = 0; ss < nsub; ++ss) {
                const int kb = lat ? c0 : 32 * ss;
                const int row0 = kb + qi, row1 = row0 + 16;
                const bf16x8 k00 = *(const LAS bf16x8*)(Kb + row0 * 128 + ((g ^ (row0 & 7)) << 4)), k01 = *(const LAS bf16x8*)(Kb + row0 * 128 + (((4 + g) ^ (row0 & 7)) << 4));
                const bf16x8 k10 = *(const LAS bf16x8*)(Kb + row1 * 128 + ((g ^ (row1 & 7)) << 4)), k11 = *(const LAS bf16x8*)(Kb + row1 * 128 + (((4 + g) ^ (row1 & 7)) << 4));
                bf16x8 vf[4];
                { const int off = (kb + 4 * g) * 2;
#pragma unroll
                  for (int db = 0; db < 4; ++db) { const int d = 16 * db + qi; const LAS unsigned char* vr = Vb + d * 128;
                      const u32x2 lo = *(const LAS u32x2*)(vr + ((((off >> 4) ^ (d & 7)) << 4) | (off & 15))), hi = *(const LAS u32x2*)(vr + (((((off + 32) >> 4) ^ (d & 7)) << 4) | (off & 15)));
                      union { u32x4 u; bf16x8 v; } va; va.u.x = lo.x; va.u.y = lo.y; va.u.z = hi.x; va.u.w = hi.y; vf[db] = va.v; } }
#pragma unroll
                for (int i = 0; i < 4; ++i) {
                    const int rq = 4 * r4 + i, kr0 = min(max(rq - 4, 0), 120);
                    if (!lat || (kr >= kr0 && kr <= kr0 + 7)) {
                        f32x4 sa = __builtin_amdgcn_mfma_f32_16x16x32_bf16(k00, qf[i][0], z4, 0, 0, 0); sa = __builtin_amdgcn_mfma_f32_16x16x32_bf16(k01, qf[i][1], sa, 0, 0, 0);
                        f32x4 sb = __builtin_amdgcn_mfma_f32_16x16x32_bf16(k10, qf[i][0], z4, 0, 0, 0); sb = __builtin_amdgcn_mfma_f32_16x16x32_bf16(k11, qf[i][1], sb, 0, 0, 0);
                        if (lat) { const LAS float* bp = rpbh + (kr - rq + 7) * 31 + boff;
#pragma unroll
                            for (int j = 0; j < 4; ++j) { sa[j] = sa[j] + bp[j] + vm0[j]; sb[j] = sb[j] + bp[16 + j] + vm1[j]; } }
                        float cm = fmaxf(fmaxf(fmaxf(sa[0], sa[1]), fmaxf(sa[2], sa[3])), fmaxf(fmaxf(sb[0], sb[1]), fmaxf(sb[2], sb[3])));
                        cm = fmaxf(cm, shx<16>(cm, lane)); cm = fmaxf(cm, shx<32>(cm, lane));
                        const float mn = fmaxf(m_run[i], cm), al = __builtin_amdgcn_exp2f(m_run[i] - mn); m_run[i] = mn;
                        f32x4 p0, p1; float ps = 0.f;
#pragma unroll
                        for (int j = 0; j < 4; ++j) { p0[j] = __builtin_amdgcn_exp2f(sa[j] - mn); p1[j] = __builtin_amdgcn_exp2f(sb[j] - mn); ps += p0[j] + p1[j]; }
                        l_run[i] = l_run[i] * al + ps;
                        union { u32x4 u; bf16x8 v; } pb; pb.u = g8::pack8(p0, p1);
#pragma unroll
                        for (int db = 0; db < 4; ++db) { o[i][db] = o[i][db] * al; o[i][db] = __builtin_amdgcn_mfma_f32_16x16x32_bf16(vf[db], pb.v, o[i][db], 0, 0, 0); }
                    }
                }
            }
        }
#pragma unroll
        for (int i = 0; i < 4; ++i) {
            float lsum = l_run[i]; lsum += shx<16>(lsum, lane); lsum += shx<32>(lsum, lane);
            const float inv = 1.0f / lsum;
            bf16_t* op = ycat + (size_t)(qrow + 64 * i) * KCAT + 896 + h * 64 + 4 * g;
#pragma unroll
            for (int db = 0; db < 4; ++db) { u32x2 w; w.x = cvt_pk_bf16(o[i][db][0] * inv, o[i][db][1] * inv); w.y = cvt_pk_bf16(o[i][db][2] * inv, o[i][db][3] * inv); *(u32x2*)(op + 16 * db) = w; }
        }
    }
    asm volatile("s_waitcnt vmcnt(0)" ::: "memory");
    __builtin_amdgcn_s_barrier();
}

template <int NB>
__device__ __forceinline__ void small_tile_acc(const bf16_t* A, int lda, const bf16_t* Bt, int ldb, int K, int row0, int col0, int lane, f32x4 (&acc)[2]) {
    const int r = lane & 15, g = lane >> 4;
    const bf16_t* ap = A + (size_t)(row0 + r) * lda + 8 * g; const bf16_t* bp0 = Bt + (size_t)(col0 + r) * ldb + 8 * g; const bf16_t* bp1 = bp0 + (size_t)16 * ldb;
    for (int k0 = 0; k0 < K; k0 += 32 * NB) {
        bf16x8 af[NB], b0[NB], b1[NB];
#pragma unroll
        for (int i = 0; i < NB; ++i) { af[i] = *(const bf16x8*)(ap + k0 + 32 * i); b0[i] = *(const bf16x8*)(bp0 + k0 + 32 * i); b1[i] = *(const bf16x8*)(bp1 + k0 + 32 * i); }
#pragma unroll
        for (int i = 0; i < NB; ++i) { acc[0] = __builtin_amdgcn_mfma_f32_16x16x32_bf16(b0[i], af[i], acc[0], 0, 0, 0); acc[1] = __builtin_amdgcn_mfma_f32_16x16x32_bf16(b1[i], af[i], acc[1], 0, 0, 0); }
    }
}

typedef const __attribute__((address_space(4))) char* KargPtr;
#define INP(i) (*(const float* const volatile __attribute__((address_space(4)))*)(karg + 8 * (i)))
#define WSP(off) (opq(ws) + (off))
#define ctl ((unsigned*)WSP(WS_CTL))
#define mod ((float*)WSP(WS_MOD))
#define ropec ((float*)WSP(WS_ROPE))
#define ropes ((float*)WSP(WS_ROPE + 128 * 16 * 4))
#define s5p ((f32x2*)WSP(WS_S5P))
#define xc ((float*)WSP(WS_XC))
#define ycat ((bf16_t*)WSP(WS_Y))
#define hbuf ycat
#define h2 ycat
#define ebuf ((bf16_t*)WSP(WS_E))
#define ygelu ebuf
#define uvg ((bf16_t*)WSP(WS_UVG))
#define mbuf uvg
#define ybuf0 ((bf16_t*)WSP(WS_Y + 66 * MiB))
#define ybuf1 ((bf16_t*)WSP(WS_Y + 132 * MiB))
#define qk ((bf16_t*)WSP(WS_QK))
#define vt ((bf16_t*)WSP(WS_VT))
#define vtc ((bf16_t*)WSP(WS_VT + 32 * MiB))
#define gates (WSP(WS_G))
#define s5a ((bf16_t*)WSP(WS_S5A))
#define logits ((float*)WSP(WS_LOGITS))
#define ltok ((int*)WSP(WS_LTOK))
#define lw ((float*)WSP(WS_LW))
#define hid ((bf16_t*)WSP(WS_HID))
#define wgu ((bf16_t*)WSP(WS_WGU))
#define wdt ((bf16_t*)WSP(WS_WD))
#define xout (opq(xout_raw))

#define PHASE_IDS() const int lane = opq_v((int)__builtin_amdgcn_mbcnt_hi(~0u, __builtin_amdgcn_mbcnt_lo(~0u, (unsigned)opq_v(0)))); int wave_ = wave0; asm volatile("" : "+s"(wave_)); const int wave = wave_, tid = wave * 64 + lane; \
    const int gw = bid * NWAVES + wave; LAS unsigned char* lds = opq_l(lds0); (void)tid; (void)gw; (void)lds
#define GRID_BAR() do { if constexpr (MULTI) { XcdBarrier b_; b_.bar = (unsigned*)WSP(WS_CTL) + CW_BAR + bli * XCD_BAR_WORDS; b_.x = xb_xcc_id(); b_.st = (volatile LAS unsigned*)(opq_l(lds0) + LDS_MISC); xcd_barrier(b_); } } while (0)
template <unsigned MASK>
__device__ __forceinline__ void layer_body(const int l, KargPtr karg, unsigned char* ws, float* xout_raw, LAS unsigned char* const lds0, const int wave0, const int G, const int bid, const int NGW, const int bli) {
    constexpr bool MULTI = (MASK & (MASK - 1u)) != 0u;
    const int MROWS = (l == 0) ? NROW : NLAT;
#define wb (WSP(WS_WPL) + (size_t)l * WPL_STRIDE)
#define modl (mod + l * 5 * 6144)
        { PROBE_T0(2);
        if (PH(2)) REPS(2) { PHASE_IDS(); const float* xl_ = (l == 0 ? INP(0) : (const float*)xout); const float* xc_ = (l == 0 ? INP(2) : (const float*)xc); const float* gn_ = INP(6) + l * 1024; bf16_t* hb_ = hbuf; const bf16_t* yb_ = ybuf0; const bf16_t* yc_ = ybuf1;
          const float* mdl_ = modl;
          for (int r0 = gw; r0 < NROW; r0 += 2 * NGW) {
            const int r1 = r0 + NGW; const bool two = r1 < NROW;
            const bool lat0 = r0 < NLAT, lat1 = r1 < NLAT;
            const float* xr0 = lat0 ? (xl_ + (size_t)r0 * 1024) : (xc_ + (size_t)(r0 - NLAT) * 1024); const float* xr1 = lat1 ? (xl_ + (size_t)r1 * 1024) : (xc_ + (size_t)(r1 - NLAT) * 1024);
            const float* mr0 = mdl_ + (lat0 ? (r0 >> 13) : 4) * 6144; const float* mr1 = mdl_ + (lat1 ? (r1 >> 13) : 4) * 6144;
            norm_mod_row2(xr0, two ? xr1 : xr0, gn_, mr0, mr0 + 1024, mr1, mr1 + 1024, hb_ + (size_t)r0 * 1024, hb_ + (size_t)(two ? r1 : r0) * 1024, lane, l == 0 ? nullptr : yb_ + (size_t)r0 * 1024, l == 0 ? nullptr : yb_ + (size_t)(two ? r1 : r0) * 1024, mr0 - 6144 * 5 + 5120, mr1 - 6144 * 5 + 5120, yc_ + (size_t)r0 * 1024, yc_ + (size_t)(two ? r1 : r0) * 1024);
          } }
        GRID_BAR(); PROBE_T1(2); }
        { PROBE_T0(3);
        if (PH(3)) REPS(3) { PHASE_IDS();
            g8::SchedDense S; S.init(hbuf, wb + WO_WIN, NROW, NWIN, 1024, 1024, G, bid);
            g8::EpiWin E{WSP(0), lds + LDS_STAGE};
            g8::gemm_run(lds, 1024, 1024, 1024, S, E);
        }
        GRID_BAR(); PROBE_T1(3); }
        { PROBE_T0(4);
        if (PH(4)) REPS(4) { PHASE_IDS();
            g8::SchedS5 S{(const char*)s5a, (const char*)(wb + WO_WEND), 256u * 256u * 2u, G, bid};
            g8::EpiS5E E{ebuf};
            g8::gemm_run(lds, 256, 512, 256, S, E);
        }
        if (PH(5)) REPS(5) { PHASE_IDS();
            const int nunits = (l == 0 ? 264 : 256) * 4;
            LAS bf16_t* vnT = (LAS bf16_t*)lds;
            const float* sw = INP(10) + (size_t)l * 4 * 128 * 128; const float* sbias = INP(11) + l * 4 * 128; const float* sgam = INP(9) + l * 512;
            for (int unit = bid; unit < nunits; unit += G) {
                const int ch = unit >> 2, g = unit & 3; const int r0 = 128 * ch;
                {
                    const int p = tid >> 2, qd = tid & 3; const bf16_t* vp = uvg + (size_t)(r0 + p) * 1024 + 512 + 128 * qd; float s = 0.f, s2 = 0.f;
                    const bf16_t* gp = uvg + (size_t)(r0 + p) * 1024 + 512 + 128 * g + 32 * qd;
                    u32x4 wv[16], wg[4];
#pragma unroll
                    for (int i = 0; i < 16; ++i) wv[i] = *(const u32x4*)(vp + 8 * i);
#pragma unroll
                    for (int i = 0; i < 4; ++i) wg[i] = *(const u32x4*)(gp + 8 * i);
#pragma unroll
                    for (int i = 0; i < 16; ++i) {
#pragma unroll
                        for (int j = 0; j < 4; ++j) { const float a = bf2f(wv[i][j] & 0xffffu), b = bf2f(wv[i][j] >> 16); s += a + b; s2 += a * a + b * b; } }
                    s += shx<1>(s, lane); s += shx<2>(s, lane); s2 += shx<1>(s2, lane); s2 += shx<2>(s2, lane);
                    const float mean = s * (1.0f / 512.0f); const float var = fmaxf(s2 * (1.0f / 512.0f) - mean * mean, 0.f); const float rstd = 1.0f / sqrtf(var + EPSN);
#pragma unroll
                    for (int i = 0; i < 4; ++i) { const u32x4 w = wg[i];
#pragma unroll
                        for (int j = 0; j < 4; ++j) { const int c = 32 * qd + 8 * i + 2 * j;
                            vnT[c * 136 + p] = (bf16_t)f2bf((bf2f(w[j] & 0xffffu) - mean) * rstd * sgam[128 * g + c]);
                            vnT[(c + 1) * 136 + p] = (bf16_t)f2bf((bf2f(w[j] >> 16) - mean) * rstd * sgam[128 * g + c + 1]); } }
                }
                __syncthreads();
                {
                    const int qi = lane & 15, gq = lane >> 4; const int q = 16 * wave + qi;
                    bf16x8 wf[4];
#pragma unroll
                    for (int kk = 0; kk < 4; ++kk) { const float* wp = sw + ((size_t)g * 128 + q) * 128 + 32 * kk + 8 * gq; const f32x4 a = *(const f32x4*)wp, b = *(const f32x4*)(wp + 4);
                        union { u32x4 u; bf16x8 v; } t; t.u = g8::pack8(a, b); wf[kk] = t.v; }
                    const float bq = sbias[g * 128 + q];
                    const bf16_t* up = uvg + (size_t)(r0 + q) * 1024 + 128 * g; bf16_t* op = ycat + (size_t)(r0 + q) * KCAT + 128 * g;
#pragma unroll 2
                    for (int cb = 0; cb < 8; ++cb) { f32x4 d = {0.f, 0.f, 0.f, 0.f};
#pragma unroll
                        for (int kk = 0; kk < 4; ++kk) { const bf16x8 af = *(const LAS bf16x8*)(vnT + (16 * cb + qi) * 136 + 32 * kk + 8 * gq); d = __builtin_amdgcn_mfma_f32_16x16x32_bf16(af, wf[kk], d, 0, 0, 0); }
                        const int c = 16 * cb + 4 * gq; const u32x2 uu = *(const u32x2*)(up + c); u32x2 w;
                        w.x = cvt_pk_bf16(bf2f(uu.x & 0xffffu) * (d[0] + bq), bf2f(uu.x >> 16) * (d[1] + bq)); w.y = cvt_pk_bf16(bf2f(uu.y & 0xffffu) * (d[2] + bq), bf2f(uu.y >> 16) * (d[3] + bq));
                        *(u32x2*)(op + c) = w; }
                }
                __syncthreads();
            }
        }
        GRID_BAR(); PROBE_T1(4); }
        { PROBE_T0(6);
        if (PH(6)) REPS(6) { PHASE_IDS();
            LAS float* rpbS = (LAS float*)lds + 64;
            { const float* rp_ = INP(21) + (size_t)l * 8 * 465; for (int i = tid; i < 8 * 465 + 128; i += NTHR) { const int k = i - 64; ((LAS float*)lds)[i] = (k >= 0 && k < 8 * 465) ? rp_[k] * 1.4426950408889634f : 0.f; } }
            __syncthreads();
            if (bid < 192) {
                const int b = bid / 48, g = (bid % 48) >> 1, dir = bid & 1;
                const f32x2 lam16 = s5p[(size_t)((l * 2 + dir) * 24 + g) * 3136 + 16 * 64 + lane];
                const bf16_t* eb = ebuf + (size_t)g * S5R * 256 + dir * 128 + lane; bf16_t* cb = s5a + (size_t)g * S5R * 512 + 256 + dir * 128 + lane;
                LAS f32x2* segT = (LAS f32x2*)(lds + 16384);
                float cr = 0.f, ci = 0.f, dr = 1.f, di = 0.f;
                for (int jb = 0; jb < 66; jb += 33) { float er[33], ei[33];
#pragma unroll
                    for (int j = 0; j < 33; ++j) { const int k = 66 * wave + jb + j; const int R = (k < 16) ? (2048 + 16 * b + (dir ? 15 - k : k)) : (512 * b + (dir ? 527 - k : k - 16));
                        er[j] = bf2f(eb[(size_t)R * 256]); ei[j] = bf2f(eb[(size_t)R * 256 + 64]); }
#pragma unroll
                    for (int j = 0; j < 33; ++j) { const float nr = lam16.x * cr - lam16.y * ci + er[j], ni = lam16.x * ci + lam16.y * cr + ei[j]; cr = nr; ci = ni;
                        const float tr = dr * lam16.x - di * lam16.y, ti = dr * lam16.y + di * lam16.x; dr = tr; di = ti; } }
                segT[wave * 64 + lane] = (f32x2){cr, ci};
                __syncthreads();
                float ar = 0.f, ai = 0.f;
                for (int s = 0; s < wave; ++s) { const f32x2 t = segT[s * 64 + lane]; const float nr = dr * ar - di * ai + t.x, ni = dr * ai + di * ar + t.y; ar = nr; ai = ni; }
                for (int jb = 0; jb < 66; jb += 33) { float er[33], ei[33];
#pragma unroll
                    for (int j = 0; j < 33; ++j) { const int k = 66 * wave + jb + j; const int R = (k < 16) ? (2048 + 16 * b + (dir ? 15 - k : k)) : (512 * b + (dir ? 527 - k : k - 16));
                        er[j] = bf2f(eb[(size_t)R * 256]); ei[j] = bf2f(eb[(size_t)R * 256 + 64]); }
#pragma unroll
                    for (int j = 0; j < 33; ++j) { const int k = 66 * wave + jb + j; const int R = (k < 16) ? (2048 + 16 * b + (dir ? 15 - k : k)) : (512 * b + (dir ? 527 - k : k - 16));
                        cb[(size_t)R * 512] = (bf16_t)f2bf(ar); cb[(size_t)R * 512 + 64] = (bf16_t)f2bf(ai);
                        const float nr = lam16.x * ar - lam16.y * ai + er[j], ni = lam16.x * ai + lam16.y * ar + ei[j]; ar = nr; ai = ni; } }
            }
            __syncthreads();
            if (l == 0) for (int u2 = (G > 192 ? gw - 192 * NWAVES : gw); u2 < 512; u2 += (G > 192 ? (G - 192) * NWAVES : NGW)) { if (u2 < 0) break;     const int qt = u2 & 15, h = (u2 >> 4) & 7, b = u2 >> 7;
                attn_tile<false>(qk, vt, vtc, ycat, rpbS, b, h, NLAT + b * 256 + 16 * qt, 0, 0, (int)__builtin_amdgcn_mbcnt_hi(~0u, __builtin_amdgcn_mbcnt_lo(~0u, (unsigned)opq_v(0)))); }
            attn_lat_phase(lds, qk, vt, vtc, ycat, rpbS, G, bid, wave, (int)__builtin_amdgcn_mbcnt_hi(~0u, __builtin_amdgcn_mbcnt_lo(~0u, (unsigned)opq_v(0))));
        }
        GRID_BAR(); PROBE_T1(6); }
        { PROBE_T0(7);
        if (PH(7)) REPS(7) { PHASE_IDS();
            g8::SchedS5 S{(const char*)s5a, (const char*)(wb + WO_KT), 256u * 512u * 2u, G, bid};
            g8::EpiS5Y E{ygelu};
            g8::gemm_run(lds, 512, 512, 512, S, E);
        }
        GRID_BAR(); PROBE_T1(7); }
        { PROBE_T0(8);
        if (PH(8)) REPS(8) { PHASE_IDS();
            g8::SchedDense S; S.init(ygelu, wb + WO_GLU, NLAT, 512, 384, 384, G, bid);
            g8::EpiGlu E{ygelu, ycat};
            g8::gemm_run(lds, 384, 384, 384, S, E);
            if (l == 0) {
                const bf16_t* yg_ = ygelu; bf16_t* yc_ = ycat; const bf16_t* gw_ = (const bf16_t*)(wb + WO_GLU);
                for (int t = bid; t < 96; t += G) { const int row0 = NLAT + 64 * (t / 6) + 16 * (wave >> 1), col0 = 64 * (t % 6) + 32 * (wave & 1);
                    f32x4 a[2] = {{0.f, 0.f, 0.f, 0.f}, {0.f, 0.f, 0.f, 0.f}};
                    small_tile_acc<6>(yg_, 384, gw_, 384, 384, row0, col0, lane, a);
                    const size_t row = (size_t)(row0 + (lane & 15));
#pragma unroll
                    for (int blk = 0; blk < 2; ++blk) { const int col = col0 + 16 * blk + 4 * (lane >> 4); const u32x2 y = *(const u32x2*)(yg_ + row * 384 + col); u32x2 w;
                        w.x = cvt_pk_bf16(bf2f(y.x & 0xffffu) * sigmoidf_(a[blk][0]), bf2f(y.x >> 16) * sigmoidf_(a[blk][1])); w.y = cvt_pk_bf16(bf2f(y.y & 0xffffu) * sigmoidf_(a[blk][2]), bf2f(y.y >> 16) * sigmoidf_(a[blk][3]));
                        *(u32x2*)(yc_ + row * KCAT + 512 + col) = w; } }
            }
        }
        GRID_BAR(); PROBE_T1(8); }
        { PROBE_T0(9);
        if (PH(9)) REPS(9) { PHASE_IDS();
            g8::SchedMerge S; S.init(ycat, wb + WO_WCAT, NLAT, G, bid); g8::EpiMerge E{gates, mbuf}; g8::gemm_run(lds, KCAT, KCAT, KCAT, S, E);
            if (l == 0) {
                const bf16_t* yc_ = ycat; const bf16_t* wc_ = (const bf16_t*)(wb + WO_WCAT); const unsigned char* gt_ = gates; bf16_t* mb_ = mbuf;
                for (int t = bid; t < 256; t += G) { const int row0 = NLAT + 64 * (t >> 4) + 16 * (wave >> 1), col0 = 64 * (t & 15) + 32 * (wave & 1);
                    f32x4 ya[2] = {{0.f, 0.f, 0.f, 0.f}, {0.f, 0.f, 0.f, 0.f}}, yb[2] = {{0.f, 0.f, 0.f, 0.f}, {0.f, 0.f, 0.f, 0.f}}, yd[2] = {{0.f, 0.f, 0.f, 0.f}, {0.f, 0.f, 0.f, 0.f}};
                    small_tile_acc<8>(yc_, KCAT, wc_, KCAT, 512, row0, col0, lane, ya);
                    small_tile_acc<6>(yc_ + 512, KCAT, wc_ + 512, KCAT, 384, row0, col0, lane, yb);
                    small_tile_acc<8>(yc_ + 896, KCAT, wc_ + 896, KCAT, 512, row0, col0, lane, yd);
                    const size_t row = (size_t)(row0 + (lane & 15));
#pragma unroll
                    for (int blk = 0; blk < 2; ++blk) { const int col = col0 + 16 * blk + 4 * (lane >> 4); const unsigned char* gp = gt_ + row * 3072 + col;
                        const unsigned ga = *(const unsigned*)gp, gb = *(const unsigned*)(gp + 1024), gc = *(const unsigned*)(gp + 2048); float v[4];
#pragma unroll
                        for (int k = 0; k < 4; ++k) v[k] = (ya[blk][k] * (float)((ga >> (8 * k)) & 255u) + yb[blk][k] * (float)((gb >> (8 * k)) & 255u) + yd[blk][k] * (float)((gc >> (8 * k)) & 255u)) * (1.0f / 255.0f);
                        u32x2 w; w.x = cvt_pk_bf16(v[0], v[1]); w.y = cvt_pk_bf16(v[2], v[3]); *(u32x2*)(mb_ + row * 1024 + col) = w; } }
            }
        }
        GRID_BAR(); PROBE_T1(9); }
        { PROBE_T0(10);
        if (PH(10)) REPS(10) { PHASE_IDS();
            g8::SchedDense S; S.init(mbuf, wb + WO_WOUT, NLAT, 1024, 1024, 1024, G, bid);
            g8::EpiWout E{(l == 0 && rep_ == 0) ? INP(0) : (const float*)xout, (l == 0 && rep_ == 0) ? INP(2) : (const float*)xc, xout, xc, modl, rep_ == 0 ? 1.f : 0.f};
            g8::gemm_run(lds, 1024, 1024, 1024, S, E);
            if (l == 0 && rep_ == 0) {
                const bf16_t* mb_ = mbuf; const bf16_t* wo_ = (const bf16_t*)(wb + WO_WOUT); const float* ci_ = INP(2); float* xc_ = xc; const float* g1_ = modl + 4 * 6144 + 2048;
                for (int t = bid; t < 256; t += G) { const int row0 = NLAT + 64 * (t >> 4) + 16 * (wave >> 1), col0 = 64 * (t & 15) + 32 * (wave & 1);
                    f32x4 a[2] = {{0.f, 0.f, 0.f, 0.f}, {0.f, 0.f, 0.f, 0.f}};
                    small_tile_acc<8>(mb_, 1024, wo_, 1024, 1024, row0, col0, lane, a);
                    const size_t rc = (size_t)(row0 - NLAT + (lane & 15));
#pragma unroll
                    for (int blk = 0; blk < 2; ++blk) { const int col = col0 + 16 * blk + 4 * (lane >> 4); const f32x4 xo = *(const f32x4*)(ci_ + rc * 1024 + col), gv = *(const f32x4*)(g1_ + col);
                        *(f32x4*)(xc_ + rc * 1024 + col) = xo + gv * a[blk]; } }
            }
        }
        GRID_BAR(); PROBE_T1(10); }
        { PROBE_T0(11);
        if (PH(11)) REPS(11) { PHASE_IDS(); const float* xl_ = xout; const float* xc_ = xc; const float* gn_ = INP(7) + l * 1024; bf16_t* hb_ = h2;
          const float* mdl_ = modl;
          for (int r0 = gw; r0 < MROWS; r0 += 2 * NGW) {
            const int r1 = r0 + NGW; const bool two = r1 < MROWS;
            const bool lat0 = r0 < NLAT, lat1 = r1 < NLAT;
            const float* xr0 = lat0 ? (xl_ + (size_t)r0 * 1024) : (xc_ + (size_t)(r0 - NLAT) * 1024); const float* xr1 = lat1 ? (xl_ + (size_t)r1 * 1024) : (xc_ + (size_t)(r1 - NLAT) * 1024);
            const float* mr0 = mdl_ + (lat0 ? (r0 >> 13) : 4) * 6144; const float* mr1 = mdl_ + (lat1 ? (r1 >> 13) : 4) * 6144;
            norm_mod_row2(xr0, two ? xr1 : xr0, gn_, mr0 + 3072, mr0 + 4096, mr1 + 3072, mr1 + 4096, hb_ + (size_t)r0 * 1024, hb_ + (size_t)(two ? r1 : r0) * 1024, lane, nullptr, nullptr);
          } }
        GRID_BAR(); PROBE_T1(11); }
        { PROBE_T0(12);
        if (PH(12)) { PHASE_IDS();
            g8::SchedDense S; S.init(h2, wb + WO_WR, MROWS, 256, 1024, 1024, G, bid);
            g8::EpiLogits E{logits};
            g8::gemm_run(lds, 1024, 1024, 1024, S, E);
            { g8::GUnit ru; for (int ui_ = 0; S.next(ui_, ru); ++ui_) {
            unsigned* cntg = ctl + CW_CNT + l * 64 * 32; const float* rgb = INP(27) + l * 4; const float* reb = INP(29) + l * 32; const float* lg_ = logits; int* lt_ = ltok; float* lw_ = lw;
            LAS unsigned* hist = (LAS unsigned*)lds; LAS unsigned* lbase = hist + 64;
            __syncthreads(); if (tid < 64) hist[tid] = 0u;
            __syncthreads();
            const int r = ru.pm * 256 + tid; const bool act = tid < 256;
            int L0 = 0, L1 = 0; unsigned s0 = 0, s1 = 0; float cw0 = 0.f, cw1 = 0.f;
            if (act) {
                const float* lp = lg_ + (size_t)r * 128; float v[72];
#pragma unroll
                for (int i = 0; i < 18; ++i) { const f32x4 t = *(const f32x4*)(lp + 4 * i); v[4 * i] = t.x; v[4 * i + 1] = t.y; v[4 * i + 2] = t.z; v[4 * i + 3] = t.w; }
                float lg[4]; int grp = 0; float gmax;
#pragma unroll
                for (int j = 0; j < 4; ++j) lg[j] = v[j] + v[36 + j] + rgb[j];
                gmax = lg[0];
#pragma unroll
                for (int j = 1; j < 4; ++j) if (lg[j] > gmax) { gmax = lg[j]; grp = j; }
                float gs = 0.f;
#pragma unroll
                for (int j = 0; j < 4; ++j) gs += __expf(lg[j] - gmax);
                const float gwt = 1.0f / gs;
                float le[8];
#pragma unroll
                for (int j = 0; j < 8; ++j) { float a = 0.f;
#pragma unroll
                    for (int q = 0; q < 4; ++q) a = (grp == q) ? (v[4 + 8 * q + j] + v[40 + 8 * q + j]) : a;
                    le[j] = a + reb[8 * grp + j]; }
                int i1 = 0; float v1 = le[0];
#pragma unroll
                for (int j = 1; j < 8; ++j) if (le[j] > v1) { v1 = le[j]; i1 = j; }
                int i2 = -1; float v2 = -3.4e38f;
#pragma unroll
                for (int j = 0; j < 8; ++j) if (j != i1 && le[j] > v2) { v2 = le[j]; i2 = j; }
                const float e2 = __expf(v2 - v1); const float w1 = 1.0f / (1.0f + e2), w2 = e2 * w1;
                L0 = 8 * grp + i1; L1 = 32 + 8 * grp + i2; cw0 = gwt * w1; cw1 = gwt * w2;
                s0 = __hip_atomic_fetch_add(hist + L0, 1u, __ATOMIC_RELAXED, __HIP_MEMORY_SCOPE_WORKGROUP); s1 = __hip_atomic_fetch_add(hist + L1, 1u, __ATOMIC_RELAXED, __HIP_MEMORY_SCOPE_WORKGROUP);
            }
            __syncthreads();
            if (tid < 64) { const unsigned c = hist[tid]; lbase[tid] = c ? atomicAdd(cntg + tid * 32, c) : 0u; }
            __syncthreads();
            if (act) { const unsigned p0 = lbase[L0] + s0, p1 = lbase[L1] + s1;
                lt_[(size_t)L0 * LCAP + p0] = r; lw_[(size_t)L0 * LCAP + p0] = cw0;
                lt_[(size_t)L1 * LCAP + p1] = r; lw_[(size_t)L1 * LCAP + p1] = cw1; }
            } }
        }
        if (PH(12)) REPS(12) { PHASE_IDS();
            LAS float* scr = (LAS float*)(lds + wave * 8448);
            const int nu_ = MROWS / 256; const int w0_ = (G > nu_) ? (bid - nu_) * NWAVES + wave : gw, nw_ = (G > nu_) ? (G - nu_) * NWAVES : NGW;
            if (w0_ >= 0) for (int it = w0_; it < 32 * 384; it += nw_) { const int e = it / 384; int r = it % 384;
                if (r < 256) { const int up = r >> 7; r &= 127; const int kb = r >> 3, nb = r & 7, n0 = 32 * nb;
                    tr_item((up ? INP(31) : INP(30)) + ((size_t)(l * 32 + e) * 1024) * 256, 256, 64 * kb, n0, wgu + (size_t)e * 512 * 1024, 1024, 256 * (n0 >> 7) + 128 * up + (n0 & 127), 64 * kb, scr, lane); }
                else { r -= 256; const int kb = r >> 5, nb = r & 31; tr_item(INP(32) + ((size_t)(l * 32 + e) * 256) * 1024, 1024, 64 * kb, 32 * nb, wdt + (size_t)e * 1024 * 256, 256, 32 * nb, 64 * kb, scr, lane); }
            }
        }
        GRID_BAR(); PROBE_T1(12); }
#define MOE_TABLES() LAS int* tstart = (LAS int*)(lds + LDS_MISC) + 16; LAS int* lcnt = (LAS int*)(lds + LDS_MISC) + 96; \
            if (tid < 64) lcnt[tid] = (int)__hip_atomic_load(ctl + CW_CNT + (l * 64 + tid) * 32, __ATOMIC_RELAXED, __HIP_MEMORY_SCOPE_AGENT); \
            __syncthreads(); \
            if (tid == 0) { int s = 0; for (int j = 0; j < 64; ++j) { tstart[j] = s; s += (lcnt[j] + 255) >> 8; } tstart[64] = s; } \
            __syncthreads()
        { PROBE_T0(14);
        if (PH(14)) REPS(14) { PHASE_IDS(); MOE_TABLES();
            g8::SchedMoeUp S{(const char*)h2, (const char*)wgu, ltok, tstart, lcnt, G, bid};
            g8::EpiMoeUp E{hid, lw, lcnt};
            g8::gemm_run(lds, 1024, 1024, 1024, S, E);
        }
        GRID_BAR(); PROBE_T1(14); }
        { PROBE_T0(15);
        if (PH(15)) { PHASE_IDS(); MOE_TABLES();
            g8::SchedMoeDown S{(const char*)hid, (const char*)wdt, tstart, G, bid};
            g8::EpiMoeDown E{ybuf0, ybuf1, ltok, lcnt};
            g8::gemm_run(lds, 256, 256, 256, S, E);
        }
        GRID_BAR(); PROBE_T1(15); }
}

template <unsigned MASK>
__global__ void __launch_bounds__(NTHR, 2) hybrid_fwd(Params P, int l0, int l1, int bli) {
    constexpr bool MULTI = (MASK & (MASK - 1u)) != 0u;
    extern __shared__ __attribute__((aligned(16))) unsigned char lds_raw[];
    LAS unsigned char* const lds0 = (LAS unsigned char*)lds_raw; LAS unsigned char* lds = lds0;
    volatile LAS unsigned* MISC = (volatile LAS unsigned*)(lds + LDS_MISC);
    const int tid = threadIdx.x, lane = tid & 63, wave = __builtin_amdgcn_readfirstlane(tid >> 6);
    const int G = gridDim.x, bid = blockIdx.x;
    const int gw = bid * NWAVES + wave, NGW = G * NWAVES;
    KargPtr karg = (KargPtr)__builtin_amdgcn_kernarg_segment_ptr();
    unsigned char* ws = *(unsigned char* const volatile __attribute__((address_space(4)))*)(karg + 8 * 35);
    for (int u = tid; u < 256; u += NTHR) MISC[u] = 0u;
    __syncthreads();
    if constexpr (MULTI) (void)xcd_barrier_post((unsigned*)(ws + WS_CTL) + CW_BAR + bli * XCD_BAR_WORDS, MISC);
    const int wave0 = wave;

    float* xout_raw = *(float* const volatile __attribute__((address_space(4)))*)(karg + 8 * 34);

    if (PH(0)) REPS(0) {
        LAS float* scr = (LAS float*)(lds + wave * 8448);
        constexpr int IT_WIN = 16 * 192, IT_A = 8 * 32, IT_B = 6 * 32, IT_C = 8 * 32, IT_O = 16 * 32, IT_G = 6 * 16, IT_L = IT_WIN + IT_A + IT_B + IT_C + IT_O + IT_G;
        for (int it = gw; it < 2 * IT_L; it += NGW) {
            const int l = it / IT_L; int r = it % IT_L; unsigned char* wbp = ws + WS_WPL + (size_t)l * WPL_STRIDE;
            if (r < IT_WIN) { const int kb = r / 192, nb = r % 192, n0 = 32 * nb; int src = -1;
                if (n0 < 1024) src = n0; else if (n0 < 2560) src = 1408 + (n0 - 1024); else if (n0 < 5632) src = 2944 + (n0 - 2560); else if (n0 < 6016) src = 1024 + (n0 - 5632);
                tr_item(src >= 0 ? INP(8) + (size_t)l * 1024 * 6016 : nullptr, 6016, 64 * kb, src, (bf16_t*)(wbp + WO_WIN), 1024, n0, 64 * kb, scr, lane); continue; } r -= IT_WIN;
            if (r < IT_A) { tr_item(INP(22) + (size_t)l * 512 * 1024, 1024, 64 * (r / 32), 32 * (r % 32), (bf16_t*)(wbp + WO_WCAT), KCAT, 32 * (r % 32), 64 * (r / 32), scr, lane); continue; } r -= IT_A;
            if (r < IT_B) { tr_item(INP(23) + (size_t)l * 384 * 1024, 1024, 64 * (r / 32), 32 * (r % 32), (bf16_t*)(wbp + WO_WCAT), KCAT, 32 * (r % 32), 512 + 64 * (r / 32), scr, lane); continue; } r -= IT_B;
            if (r < IT_C) { tr_item(INP(24) + (size_t)l * 512 * 1024, 1024, 64 * (r / 32), 32 * (r % 32), (bf16_t*)(wbp + WO_WCAT), KCAT, 32 * (r % 32), 896 + 64 * (r / 32), scr, lane); continue; } r -= IT_C;
            if (r < IT_O) { tr_item(INP(25) + (size_t)l * 1024 * 1024, 1024, 64 * (r / 32), 32 * (r % 32), (bf16_t*)(wbp + WO_WOUT), 1024, 32 * (r % 32), 64 * (r / 32), scr, lane); continue; } r -= IT_O;
            { const int kb = r / 16, nb = r % 16; tr_item(nb < 12 ? INP(20) + (size_t)l * 384 * 384 : nullptr, 384, 64 * kb, 32 * nb, (bf16_t*)(wbp + WO_GLU), 384, 32 * nb, 64 * kb, scr, lane); }
        }
        const float* rgw = INP(26); const float* rew = INP(28);
        for (int idx = bid * NTHR + tid; idx < 2 * 256 * 1024; idx += G * NTHR) {
            const int l = idx >> 18, n = (idx >> 10) & 255, k = idx & 1023; float w = 0.f; int lo = 0, j = n;
            if (n >= 36 && n < 72) { lo = 1; j = n - 36; }
            if (n < 72) w = j < 4 ? rgw[(size_t)l * 1024 * 4 + k * 4 + j] : rew[(size_t)l * 1024 * 32 + k * 32 + (j - 4)];
            const unsigned hb = f2bf(w); const float res = lo ? (w - bf2f(hb)) : 0.f;
            ((bf16_t*)(ws + WS_WPL + (size_t)l * WPL_STRIDE + WO_WR))[n * 1024 + k] = (bf16_t)(lo ? f2bf(res) : hb);
        }
        for (int idx = bid * NTHR + tid; idx < 128 * 16; idx += G * NTHR) {
            const int pos = idx >> 4, f = idx & 15; const float inv = powf(10000.0f, -(float)f / 16.0f); const float ang = (float)pos * inv;
            ropec[idx] = cosf(ang); ropes[idx] = sinf(ang);
        }
        const float* s5bre = INP(15); const float* s5bim = INP(16); const float* s5cre = INP(17); const float* s5cim = INP(18);
        for (int e = bid * NTHR + tid; e < 17 * 2 * 2 * 24 * 64; e += G * NTHR) {
            const int d = e / 6144, idx = e - d * 6144; const int p = idx & 63, ldg = idx >> 6;
            const float dt = expf(INP(14)[ldg]); const float zr = INP(12)[idx] * dt, zi = INP(13)[idx] * dt; const float ex = expf(zr * (float)d);
            s5p[(size_t)ldg * 3136 + d * 64 + p] = (f32x2){ex * cosf(zi * (float)d), ex * sinf(zi * (float)d)};
        }
        for (int idx = bid * NTHR + tid; idx < 2 * 2 * 24 * 64; idx += G * NTHR) {
            const int p = idx & 63, ldg = idx >> 6;
            const float are = INP(12)[idx], aim = INP(13)[idx]; const float dt = expf(INP(14)[ldg]);
            const float zr = are * dt, zi = aim * dt;
            f32x2* base = s5p + (size_t)ldg * 3136;
            const float e1 = expf(zr), lr = e1 * cosf(zi) - 1.0f, li = e1 * sinf(zi); const float den = 1.0f / (are * are + aim * aim);
            const float cr = (lr * are + li * aim) * den, ci = (li * are - lr * aim) * den;
            for (int c = 0; c < 16; ++c) { const float br = s5bre[(size_t)idx * 16 + c], bi = s5bim[(size_t)idx * 16 + c];
                base[1088 + p * 16 + c] = (f32x2){cr * br - ci * bi, cr * bi + ci * br};
                base[2112 + c * 64 + p] = (f32x2){s5cre[((size_t)ldg * 16 + c) * 64 + p], s5cim[((size_t)ldg * 16 + c) * 64 + p]}; }
        }
        __syncthreads();
        for (int unit = bid; unit < 2 * 96; unit += G) {
            const int l = unit / 96, n0 = 64 * (unit % 96);
            LAS float* sv = (LAS float*)lds; LAS float* part = sv + 5 * 1024;
            const float* cv = INP(1); const float* ccv = INP(3);
            for (int i = tid; i < 5 * 1024; i += NTHR) { const int m = i >> 10, k = i & 1023; const float c = m < 4 ? cv[m * 1024 + k] : ccv[k]; sv[i] = c * sigmoidf_(c); }
            __syncthreads();
            float a[5] = {0.f, 0.f, 0.f, 0.f, 0.f};
            const float* wp = INP(4) + (size_t)l * 1024 * 6144 + n0 + lane;
            for (int kb = wave * 128; kb < wave * 128 + 128; kb += 32) { float wv[32];
#pragma unroll
                for (int j = 0; j < 32; ++j) wv[j] = wp[(size_t)(kb + j) * 6144];
#pragma unroll
                for (int j = 0; j < 32; ++j) {
#pragma unroll
                    for (int m = 0; m < 5; ++m) a[m] += sv[m * 1024 + kb + j] * wv[j]; } }
#pragma unroll
            for (int m = 0; m < 5; ++m) part[(wave * 5 + m) * 64 + lane] = a[m];
            __syncthreads();
            if (tid < 320) { const int m = tid >> 6, n = tid & 63; float s = 0.f;
#pragma unroll
                for (int w = 0; w < 8; ++w) s += part[(w * 5 + m) * 64 + n];
                mod[(l * 5 + m) * 6144 + n0 + n] = s + INP(5)[l * 6144 + n0 + n]; }
            __syncthreads();
        }
    }
    GRID_BAR();
    if (PH(1)) REPS(1) for (int unit = bid; unit < 192; unit += G) {
        const int l = unit / 96, g = (unit % 96) >> 2, qt = unit & 3;
        LAS f32x2* prm = (LAS f32x2*)lds;
        LAS float* Gt = (LAS float*)(lds + 2 * 3136 * 8);
        { const f32x2* pf = s5p + (size_t)((l * 2 + 0) * 24 + g) * 3136; const f32x2* pr = s5p + (size_t)((l * 2 + 1) * 24 + g) * 3136;
          for (int i = tid; i < 3136; i += NTHR) { prm[i] = pf[i]; prm[3136 + i] = pr[i]; } }
        __syncthreads();
        for (int e = tid; e < 2048; e += NTHR) { const int dir = e >> 10, d = (e >> 6) & 15, co = 4 * qt + ((e >> 4) & 3), ci = e & 15; const LAS f32x2* pp = prm + dir * 3136; float s = 0.f;
#pragma unroll 8
            for (int p = 0; p < 64; ++p) { const f32x2 c = pp[2112 + co * 64 + p], w = pp[d * 64 + p], bb = pp[1088 + p * 16 + ci];
                const float tr = c.x * w.x - c.y * w.y, ti = c.x * w.y + c.y * w.x; s += tr * bb.x - ti * bb.y; }
            Gt[e] = s; }
        __syncthreads();
        unsigned* kt = (unsigned*)((bf16_t*)(ws + WS_WPL + (size_t)l * WPL_STRIDE + WO_KT) + (size_t)g * 256 * 512);
        unsigned* we = (unsigned*)((bf16_t*)(ws + WS_WPL + (size_t)l * WPL_STRIDE + WO_WEND) + (size_t)g * 256 * 256);
        const float* s5d = INP(19) + l * 384 + 16 * g;
        for (int idx = tid; idx < 64 * 256; idx += NTHR) { const int rr = idx >> 8, k0 = (idx & 255) * 2, m = rr >> 2, cq = rr & 3, co = 4 * qt + cq, n = 16 * m + co; float v[2];
#pragma unroll
            for (int j = 0; j < 2; ++j) { const int k = k0 + j; float x = 0.f;
                if (k < 256) { const int mp = k >> 4, ci = k & 15;
                    if (mp <= m) x += Gt[(((m - mp) * 4 + cq) * 16) + ci];
                    if (mp >= m) x += Gt[1024 + (((mp - m) * 4 + cq) * 16) + ci];
                    if (mp == m && co == ci) x += s5d[co];
                } else { const int q = (k - 256) & 127, dir = (k - 256) >> 7, p = q & 63, im = q >> 6; const LAS f32x2* pp = prm + dir * 3136;
                    const f32x2 c = pp[2112 + co * 64 + p], w = pp[(dir ? (16 - m) : (m + 1)) * 64 + p];
                    x = im ? -(c.x * w.y + c.y * w.x) : (c.x * w.x - c.y * w.y); }
                v[j] = x; }
            kt[(n * 512 + k0) >> 1] = f2bf(v[0]) | (f2bf(v[1]) << 16); }
        for (int idx = tid; idx < 64 * 128; idx += NTHR) { const int n = 64 * qt + (idx >> 7), k0 = (idx & 127) * 2, dir = n >> 7, p = n & 63, im = (n >> 6) & 1; const LAS f32x2* pp = prm + dir * 3136; float v[2];
#pragma unroll
            for (int j = 0; j < 2; ++j) { const int k = k0 + j, mp = k >> 4, ci = k & 15; const f32x2 w = pp[(dir ? mp : (15 - mp)) * 64 + p], bb = pp[1088 + p * 16 + ci];
                v[j] = im ? (w.x * bb.y + w.y * bb.x) : (w.x * bb.x - w.y * bb.y); }
            we[(n * 256 + k0) >> 1] = f2bf(v[0]) | (f2bf(v[1]) << 16); }
        __syncthreads();
    }

    if constexpr (MASK == ALL_PHASES) { layer_body<MASK>(0, karg, ws, xout_raw, lds0, wave, G, bid, NGW, bli); layer_body<MASK>(1, karg, ws, xout_raw, lds0, wave, G, bid, NGW, bli); }
    else { for (int l = l0; l < l1; ++l) layer_body<MASK>(l, karg, ws, xout_raw, lds0, wave, G, bid, NGW, bli); }
    if (PROBE_MASK != 0u) { GRID_BAR(); const unsigned long long acc_ = *(volatile unsigned long long*)(ws + WS_CTL + 4096); const unsigned long long t0_ = __builtin_amdgcn_s_memrealtime(); while (__builtin_amdgcn_s_memrealtime() - t0_ < 4ull * acc_) __builtin_amdgcn_s_sleep(8); }
#ifdef EXTRA_BARS
    for (int i_ = 0; i_ < EXTRA_BARS; ++i_) GRID_BAR();
#endif
    if (PH(17)) { PHASE_IDS(); const float* fg_ = INP(33); float* xo_ = xout; const bf16_t* yb_ = ybuf0; const bf16_t* yc_ = ybuf1; const float* g2_ = mod + 5 * 6144 + 5120;
    for (int r = gw; r < NLAT; r += NGW) {
        float* xr = xo_ + (size_t)r * 1024; f32x4* xp = (f32x4*)xr + lane; f32x4 v[4]; float s = 0.f;
#pragma unroll
        for (int j = 0; j < 4; ++j) { v[j] = xp[64 * j]; const u32x2 yy = *(const u32x2*)(yb_ + (size_t)r * 1024 + 4 * lane + 256 * j), zz = *(const u32x2*)(yc_ + (size_t)r * 1024 + 4 * lane + 256 * j); const f32x4 g2 = *(const f32x4*)(g2_ + (r >> 13) * 6144 + 4 * lane + 256 * j); v[j].x += g2.x * (bf2f(yy.x & 0xffffu) + bf2f(zz.x & 0xffffu)); v[j].y += g2.y * (bf2f(yy.x >> 16) + bf2f(zz.x >> 16)); v[j].z += g2.z * (bf2f(yy.y & 0xffffu) + bf2f(zz.y & 0xffffu)); v[j].w += g2.w * (bf2f(yy.y >> 16) + bf2f(zz.y >> 16));
            s += (v[j].x * v[j].x + v[j].y * v[j].y) + (v[j].z * v[j].z + v[j].w * v[j].w); }
        const float rr = 1.0f / sqrtf(wave_sum(s, lane) * (1.0f / DM) + EPSN);
#pragma unroll
        for (int j = 0; j < 4; ++j) { const f32x4 g = *(const f32x4*)(fg_ + 4 * lane + 256 * j); xp[64 * j] = v[j] * rr * g; }
    } }
}

template <unsigned MASK> static void launch_ph(const Params& p, int l0, int l1, int grid, hipStream_t s) {
    static bool attr = false;
    if (!attr) { if (hipFuncSetAttribute((const void*)hybrid_fwd<MASK>, hipFuncAttributeMaxDynamicSharedMemorySize, LDS_BYTES) != hipSuccess) fprintf(stderr, "kernel_launch: hipFuncSetAttribute failed\n"); attr = true; }
    hipLaunchKernelGGL(hybrid_fwd<MASK>, dim3(grid), dim3(NTHR), LDS_BYTES, s, p, l0, l1, 0);
}
extern "C" void kernel_launch(void* const* d_in, const int* in_sizes, int n_in, void* d_out, int out_size, void* d_ws, size_t ws_size, hipStream_t stream) {
    static int grid = 0;
    if (grid == 0) {
        if (n_in != 34 || out_size != NLAT * DM || ws_size < WS_END) { fprintf(stderr, "kernel_launch: unexpected problem (n_in %d, out %d, ws %zu)\n", n_in, out_size, ws_size); grid = -1; return; }
        int dev = 0, cus = 0;
        if (hipGetDevice(&dev) != hipSuccess || hipDeviceGetAttribute(&cus, hipDeviceAttributeMultiprocessorCount, dev) != hipSuccess) { grid = -1; return; }
        grid = cus;
    }
    if (grid < 0) return;
    (void)hipMemsetAsync((char*)d_ws + WS_CTL, 0, CTL_BYTES, stream);
    Params p{};
    for (int i = 0; i < 34; ++i) p.in[i] = (const float*)d_in[i];
    p.out = (float*)d_out; p.ws = (unsigned char*)d_ws;
#if N_LAUNCHES == 1
    {
        static bool q = false;
        if (!q) { q = true; int per_cu = 0; (void)hipFuncSetAttribute((const void*)hybrid_fwd<ALL_PHASES>, hipFuncAttributeMaxDynamicSharedMemorySize, LDS_BYTES);
            if (hipOccupancyMaxActiveBlocksPerMultiprocessor(&per_cu, (const void*)hybrid_fwd<ALL_PHASES>, NTHR, LDS_BYTES) != hipSuccess || per_cu < 1) fprintf(stderr, "kernel_launch: occupancy query says %d\n", per_cu);
            (void)hipGetLastError(); }
    }
    launch_ph<ALL_PHASES>(p, 0, 2, grid, stream);
#else
    launch_ph<1u << 0>(p, 0, 0, grid, stream);
    launch_ph<1u << 1>(p, 0, 0, grid, stream);
    for (int l = 0; l < 2; ++l) {
        launch_ph<1u << 2>(p, l, l + 1, grid, stream);  launch_ph<1u << 3>(p, l, l + 1, grid, stream);  launch_ph<1u << 4>(p, l, l + 1, grid, stream);
        launch_ph<1u << 5>(p, l, l + 1, grid, stream);  launch_ph<1u << 6>(p, l, l + 1, grid, stream);  launch_ph<1u << 7>(p, l, l + 1, grid, stream);
        launch_ph<1u << 8>(p, l, l + 1, grid, stream);  launch_ph<1u << 9>(p, l, l + 1, grid, stream);  launch_ph<1u << 10>(p, l, l + 1, grid, stream);
        launch_ph<1u << 11>(p, l, l + 1, grid, stream); launch_ph<1u << 12>(p, l, l + 1, grid, stream); launch_ph<1u << 13>(p, l, l + 1, grid, stream);
        launch_ph<1u << 14>(p, l, l + 1, grid, stream); launch_ph<1u << 15>(p, l, l + 1, grid, stream); launch_ph<1u << 16>(p, l, l + 1, grid, stream);
    }
    launch_ph<1u << 17>(p, 0, 0, grid, stream);
#endif
}
```
